# Optimizing an MI355X kernel written in HIP

```python
import jax, jax.numpy as jnp
from jax import lax
import numpy as np

D_MODEL = 1024
BATCH = 4
SEQ = 4096
DEPTH = 4

GRID_W = 64
CTX_LEN = 256
N_MIXERS = 3
N_LAYERS_A = (DEPTH + 2) // 3
N_LAYERS_B = (DEPTH + 1) // 3
N_LAYERS_C = DEPTH // 3
NORM_EPS = 1e-6

MLSTM_HEADS = 8
MLSTM_DQK = D_MODEL // MLSTM_HEADS // 2
MLSTM_DV = D_MODEL // MLSTM_HEADS
MLSTM_CONV = 3
MLSTM_CHUNK = 64
MLSTM_FGATE_BIAS = 3.0
MLSTM_PROJ = 2 * MLSTM_HEADS * MLSTM_DQK + 2 * D_MODEL + 4 * MLSTM_HEADS

ATTN_HEADS = 8
ATTN_KV_HEADS = 4
ATTN_HEAD_DIM = D_MODEL // ATTN_HEADS
ATTN_BLOCK = 128
ROPE_THETA = 10000.0
ATTN_PROJ = (ATTN_HEADS + 2 * ATTN_KV_HEADS) * ATTN_HEAD_DIM

GLA_HEADS = 4
GLA_DK = D_MODEL // 2 // GLA_HEADS
GLA_DV = D_MODEL // GLA_HEADS
GLA_GATE_RANK = 16
GLA_TAU = 16.0
GLA_CHUNK = 64
GLA_GATE_BIAS = 2.0
GLA_PROJ = 2 * GLA_HEADS * GLA_DK + 2 * D_MODEL + 2 * GLA_GATE_RANK

N_EXPERTS = 32
TOP_K = 4
D_EXPERT = D_MODEL
SWIGLU_LIMIT = 7.0
SWIGLU_ALPHA = 1.702
MOE_BLOCK = 128

kernel_name = "hybrid_mlstm_gqa_gla_moe_dit"

F32 = jnp.float32


def rms_norm(x, g):
    x32 = x.astype(F32)
    y = x32 * lax.rsqrt(jnp.mean(x32 * x32, axis=-1, keepdims=True) + NORM_EPS)
    return (y * g.astype(F32)).astype(x.dtype)


def modulate(x, shift, scale):
    return x * (1 + scale[:, None, :]) + shift[:, None, :]


def depthwise_conv_centred(x, w):
    return lax.conv_general_dilated(
        x, w[:, None, :].astype(x.dtype), window_strides=(1,),
        padding=[((MLSTM_CONV - 1) // 2, MLSTM_CONV // 2)],
        dimension_numbers=("NWC", "WIO", "NWC"), feature_group_count=x.shape[-1])


def to_heads(a, n_heads, d):
    b, n = a.shape[:2]
    return a.reshape(b, n, n_heads, d).transpose(0, 2, 1, 3).astype(F32)


def to_chunks(a, size):
    b, h, n = a.shape[:3]
    return jnp.moveaxis(a.reshape(b, h, n // size, size, *a.shape[3:]), 2, 0)


def from_chunks(y):
    nc, b, h, size = y.shape[:4]
    return jnp.moveaxis(y, 0, 2).reshape(b, h, nc * size, *y.shape[4:])


def bidirectional_scan(scan_fn, ctx_f, ctx_b, lat_f, lat_b, state0):
    flip = lambda t: tuple(jnp.flip(a, axis=2) for a in t)
    h_cf, s_f = scan_fn(ctx_f, state0)
    h_cb, s_b = scan_fn(flip(ctx_b), state0)
    h_lf, _ = scan_fn(lat_f, s_f)
    h_lb, _ = scan_fn(flip(lat_b), s_b)
    return h_cf + jnp.flip(h_cb, 2), h_lf + jnp.flip(h_lb, 2)


def mlstm_chunk_step(carry, xs):
    C, n, m = carry
    q, k, v, li, lf = xs
    size = q.shape[2]
    tri = jnp.tril(jnp.ones((size, size), bool))
    b = jnp.cumsum(lf, axis=-1)
    dmat = jnp.where(tri, b[..., :, None] - b[..., None, :] + li[..., None, :], -jnp.inf)
    inter = b + m[..., None]
    m_t = jnp.maximum(inter, jnp.max(dmat, axis=-1))
    w = jnp.exp(dmat - m_t[..., None])
    a_inter = jnp.exp(inter - m_t)
    s = jnp.einsum("bhtd,bhsd->bhts", q, k) * w
    num = a_inter[..., None] * jnp.einsum("bhtd,bhvd->bhtv", q, C) + jnp.einsum("bhts,bhsv->bhtv", s, v)
    den = a_inter * jnp.einsum("bhtd,bhd->bht", q, n) + jnp.sum(s, axis=-1)
    h = num / jnp.maximum(jnp.abs(den), jnp.exp(-m_t))[..., None]
    b_last = b[..., -1]
    g = b_last[..., None] - b + li
    m_new = jnp.maximum(b_last + m, jnp.max(g, axis=-1))
    decay = jnp.exp(b_last + m - m_new)
    wg = jnp.exp(g - m_new[..., None])
    C_new = decay[..., None, None] * C + jnp.einsum("bhs,bhsv,bhsd->bhvd", wg, v, k)
    n_new = decay[..., None] * n + jnp.einsum("bhs,bhsd->bhd", wg, k)
    return (C_new, n_new, m_new), h


def mlstm_scan(inputs, state):
    xs = tuple(to_chunks(a, MLSTM_CHUNK) for a in inputs)
    state, h = lax.scan(mlstm_chunk_step, state, xs)
    return from_chunks(h), state


def mlstm_mixer(u_ctx, u_lat, w_in, conv_w, gate_b, norm_g, w_out, need_ctx):
    H, dk, dv, D = MLSTM_HEADS, MLSTM_DQK, MLSTM_DV, D_MODEL

    def project(u):
        p = u @ w_in
        b_, n_ = u.shape[:2]
        qk = jax.nn.silu(depthwise_conv_centred(p[..., :2 * H * dk], conv_w))
        q = to_heads(qk[..., :H * dk], H, dk) * dk ** -0.5
        k = to_heads(qk[..., H * dk:], H, dk)
        v = to_heads(p[..., 2 * H * dk:2 * H * dk + D], H, dv)
        o = p[..., 2 * H * dk + D:2 * H * dk + 2 * D]
        gates = p[..., 2 * H * dk + 2 * D:].reshape(b_, n_, 4, H).astype(F32) + gate_b
        gates = gates.transpose(2, 0, 3, 1)
        fwd = (q, k, v, gates[0], jax.nn.log_sigmoid(gates[1]))
        bwd = (q, k, v, gates[2], jax.nn.log_sigmoid(gates[3]))
        return fwd, bwd, o

    cf, cb, o_ctx = project(u_ctx)
    lf, lb, o_lat = project(u_lat)
    b_ = u_lat.shape[0]
    state0 = (jnp.zeros((b_, H, dv, dk), F32), jnp.zeros((b_, H, dk), F32), jnp.zeros((b_, H), F32))
    h_ctx, h_lat = bidirectional_scan(mlstm_scan, cf, cb, lf, lb, state0)

    def readout(h, o):
        hh = rms_norm(jnp.swapaxes(h, 1, 2), norm_g.reshape(H, dv))
        hh = hh.reshape(hh.shape[0], hh.shape[1], D) * jax.nn.sigmoid(o.astype(F32))
        return hh.astype(o.dtype) @ w_out

    return (readout(h_ctx, o_ctx) if need_ctx else None), readout(h_lat, o_lat)


def rope_axis(x, pos):
    half = x.shape[-1] // 2
    inv = ROPE_THETA ** (-jnp.arange(half, dtype=F32) / half)
    ang = pos[:, None] * inv
    cos, sin = jnp.cos(ang)[:, None, :], jnp.sin(ang)[:, None, :]
    x1, x2 = x[..., :half], x[..., half:]
    return jnp.concatenate([x1 * cos - x2 * sin, x1 * sin + x2 * cos], axis=-1)


def rope_2d(x, rows, cols):
    half = x.shape[-1] // 2
    x32 = x.astype(F32)
    out = jnp.concatenate([rope_axis(x32[..., :half], rows), rope_axis(x32[..., half:], cols)], axis=-1)
    return out.astype(x.dtype)


def attend(qb, keys, vals):
    s = jnp.einsum("bqkgd,bnkd->bkgqn", qb, keys).astype(F32) * ATTN_HEAD_DIM ** -0.5
    p = jax.nn.softmax(s, axis=-1).astype(vals.dtype)
    return jnp.einsum("bkgqn,bnkd->bqkgd", p, vals)


def gqa_mixer(u_ctx, u_lat, w_in, q_norm_g, k_norm_g, w_out, need_ctx):
    Hq, Hkv, Dh, D = ATTN_HEADS, ATTN_KV_HEADS, ATTN_HEAD_DIM, D_MODEL
    G = Hq // Hkv

    def project(u):
        p = u @ w_in
        b_, n_ = u.shape[:2]
        q = rms_norm(p[..., :Hq * Dh].reshape(b_, n_, Hq, Dh), q_norm_g)
        k = rms_norm(p[..., Hq * Dh:(Hq + Hkv) * Dh].reshape(b_, n_, Hkv, Dh), k_norm_g)
        v = p[..., (Hq + Hkv) * Dh:].reshape(b_, n_, Hkv, Dh)
        return q, k, v

    qc, kc, vc = project(u_ctx)
    ql, kl, vl = project(u_lat)
    b_, n_lat = u_lat.shape[:2]
    n_rows = n_lat // GRID_W
    rows = jnp.repeat(jnp.arange(n_rows, dtype=F32), GRID_W)
    cols = jnp.tile(jnp.arange(GRID_W, dtype=F32), n_rows)
    ql = rope_2d(ql, rows, cols)
    kl = rope_2d(kl, rows, cols)
    keys = jnp.concatenate([kc, kl], axis=1)
    vals = jnp.concatenate([vc, vl], axis=1)

    n_blk = n_lat // ATTN_BLOCK
    qlb = ql.reshape(b_, n_blk, ATTN_BLOCK, Hkv, G, Dh).transpose(1, 0, 2, 3, 4, 5)
    out = lax.map(lambda qb: attend(qb, keys, vals), qlb)
    y_lat = out.transpose(1, 0, 2, 3, 4, 5).reshape(b_, n_lat, D) @ w_out
    y_ctx = None
    if need_ctx:
        n_ctx = u_ctx.shape[1]
        y_ctx = attend(qc.reshape(b_, n_ctx, Hkv, G, Dh), kc, vc).reshape(b_, n_ctx, D) @ w_out
    return y_ctx, y_lat


def gla_chunk_step(S, xs):
    q, k, v, la = xs
    size = q.shape[2]
    tri = jnp.tril(jnp.ones((size, size), bool))
    b = jnp.cumsum(la, axis=2)
    o_inter = jnp.einsum("bhtd,bhdv->bhtv", q * jnp.exp(b), S)
    dec = jnp.exp(jnp.where(tri[:, :, None], b[:, :, :, None, :] - b[:, :, None, :, :], -jnp.inf))
    a = jnp.einsum("bhtd,bhtsd,bhsd->bhts", q, dec, k)
    o = o_inter + jnp.einsum("bhts,bhsv->bhtv", a, v)
    b_last = b[:, :, -1]
    S_new = jnp.exp(b_last)[..., None] * S + jnp.einsum(
        "bhsd,bhsv->bhdv", k * jnp.exp(b_last[:, :, None, :] - b), v)
    return S_new, o


def gla_scan(inputs, S):
    xs = tuple(to_chunks(a, GLA_CHUNK) for a in inputs)
    S, o = lax.scan(gla_chunk_step, S, xs)
    return from_chunks(o), S


def gla_mixer(u_ctx, u_lat, w_in, alpha_w2, alpha_b, norm_g, w_out, need_ctx):
    H, dk, dv, R, D = GLA_HEADS, GLA_DK, GLA_DV, GLA_GATE_RANK, D_MODEL

    def project(u):
        p = u @ w_in
        b_, n_ = u.shape[:2]
        q = to_heads(p[..., :H * dk], H, dk) * dk ** -0.5
        k = to_heads(p[..., H * dk:2 * H * dk], H, dk)
        v = to_heads(p[..., 2 * H * dk:2 * H * dk + D], H, dv)
        g = p[..., 2 * H * dk + D:2 * H * dk + 2 * D]
        a_low = p[..., 2 * H * dk + 2 * D:].reshape(b_, n_, 2, R)
        la = jax.nn.log_sigmoid(jnp.einsum("bnjr,jrc->bnjc", a_low, alpha_w2).astype(F32) + alpha_b) / GLA_TAU
        fwd = (q, k, v, to_heads(la[:, :, 0], H, dk))
        bwd = (q, k, v, to_heads(la[:, :, 1], H, dk))
        return fwd, bwd, g

    cf, cb, g_ctx = project(u_ctx)
    lf, lb, g_lat = project(u_lat)
    state0 = jnp.zeros((u_lat.shape[0], H, dk, dv), F32)
    h_ctx, h_lat = bidirectional_scan(gla_scan, cf, cb, lf, lb, state0)

    def readout(h, g):
        hh = rms_norm(jnp.swapaxes(h, 1, 2), norm_g.reshape(H, dv))
        hh = hh.reshape(hh.shape[0], hh.shape[1], D) * jax.nn.silu(g.astype(F32))
        return hh.astype(g.dtype) @ w_out

    return (readout(h_ctx, g_ctx) if need_ctx else None), readout(h_lat, g_lat)


def moe(x, w_r, b_r, w_gu, b_gu, w_d, b_d):
    T, D = x.shape
    logits = (x @ w_r).astype(F32) + b_r
    top_logit, top_e = lax.top_k(logits, TOP_K)
    gate = jax.nn.softmax(top_logit, axis=-1)
    n_assign = T * TOP_K
    flat_e = top_e.reshape(-1)
    flat_t = jnp.repeat(jnp.arange(T, dtype=jnp.int32), TOP_K)
    flat_g = gate.reshape(-1)
    order = jnp.argsort(flat_e)
    e_sorted = flat_e[order]
    counts = jnp.bincount(flat_e, length=N_EXPERTS)
    starts = jnp.cumsum(counts) - counts
    padded = (counts + MOE_BLOCK - 1) // MOE_BLOCK * MOE_BLOCK
    pad_ends = jnp.cumsum(padded)
    pad_starts = pad_ends - padded
    dest = pad_starts[e_sorted] + jnp.arange(n_assign, dtype=jnp.int32) - starts[e_sorted]
    cap = (-(-n_assign // MOE_BLOCK) + N_EXPERTS) * MOE_BLOCK
    tok_buf = jnp.full((cap,), T, jnp.int32).at[dest].set(flat_t[order])
    gate_buf = jnp.zeros((cap,), x.dtype).at[dest].set(flat_g[order].astype(x.dtype))
    n_blocks = cap // MOE_BLOCK
    block_e = jnp.minimum(jnp.searchsorted(pad_ends, jnp.arange(n_blocks, dtype=jnp.int32) * MOE_BLOCK,
                                           side="right"), N_EXPERTS - 1)
    x_pad = jnp.concatenate([x, jnp.zeros((1, D), x.dtype)], axis=0)
    xb = x_pad[tok_buf].reshape(n_blocks, MOE_BLOCK, D)

    def expert_block(args):
        xs, e = args
        gu = xs @ w_gu[e] + b_gu[e]
        g = jnp.minimum(gu[:, :D_EXPERT], SWIGLU_LIMIT)
        lin = jnp.clip(gu[:, D_EXPERT:], -SWIGLU_LIMIT, SWIGLU_LIMIT)
        hdn = g * jax.nn.sigmoid(SWIGLU_ALPHA * g) * (lin + 1)
        return hdn @ w_d[e] + b_d[e]

    yb = lax.map(expert_block, (xb, block_e)).reshape(cap, D)
    out = jnp.zeros((T + 1, D), x.dtype).at[tok_buf].add(yb * gate_buf[:, None])
    return out[:T]


def setup_inputs(seed: int = 0) -> dict:
    key = jax.random.key(seed)
    ks = iter(jax.random.split(key, 40))
    nrm = lambda shape, scale: jax.random.normal(next(ks), shape, jnp.float32) * scale
    D = D_MODEL
    d_in = D ** -0.5
    fgate_off = jnp.array([0.0, MLSTM_FGATE_BIAS, 0.0, MLSTM_FGATE_BIAS], jnp.float32)[None, :, None]
    return {
        "x": nrm((BATCH, SEQ, D), 1.0),
        "c": nrm((BATCH, D), 1.0),
        "ctx": nrm((BATCH, CTX_LEN, D), 1.0),
        "c_ctx": nrm((D,), 1.0),
        "norm1_g": 1.0 + nrm((DEPTH, D), 0.02),
        "norm2_g": 1.0 + nrm((DEPTH, D), 0.02),
        "mod_w": nrm((DEPTH, D, 6 * D), 0.5 * d_in),
        "mod_b": nrm((DEPTH, 6 * D), 0.02),
        "mlstm_w_in": nrm((N_LAYERS_A, D, MLSTM_PROJ), d_in),
        "mlstm_conv_w": nrm((N_LAYERS_A, MLSTM_CONV, 2 * MLSTM_HEADS * MLSTM_DQK), MLSTM_CONV ** -0.5),
        "mlstm_gate_b": nrm((N_LAYERS_A, 4, MLSTM_HEADS), 0.1) + fgate_off,
        "mlstm_out_norm_g": 1.0 + nrm((N_LAYERS_A, D), 0.02),
        "mlstm_w_out": nrm((N_LAYERS_A, D, D), d_in),
        "attn_w_in": nrm((N_LAYERS_B, D, ATTN_PROJ), d_in),
        "attn_q_norm_g": 1.0 + nrm((N_LAYERS_B, ATTN_HEAD_DIM), 0.02),
        "attn_k_norm_g": 1.0 + nrm((N_LAYERS_B, ATTN_HEAD_DIM), 0.02),
        "attn_w_out": nrm((N_LAYERS_B, D, D), d_in),
        "gla_w_in": nrm((N_LAYERS_C, D, GLA_PROJ), d_in),
        "gla_alpha_w2": nrm((N_LAYERS_C, 2, GLA_GATE_RANK, GLA_HEADS * GLA_DK), GLA_GATE_RANK ** -0.5),
        "gla_alpha_b": nrm((N_LAYERS_C, 2, GLA_HEADS * GLA_DK), 0.1) + GLA_GATE_BIAS,
        "gla_out_norm_g": 1.0 + nrm((N_LAYERS_C, D), 0.02),
        "gla_w_out": nrm((N_LAYERS_C, D, D), d_in),
        "router_w": nrm((DEPTH, D, N_EXPERTS), d_in),
        "router_b": nrm((DEPTH, N_EXPERTS), 0.01),
        "moe_w_gu": nrm((DEPTH, N_EXPERTS, D, 2 * D_EXPERT), d_in),
        "moe_b_gu": nrm((DEPTH, N_EXPERTS, 2 * D_EXPERT), 0.02),
        "moe_w_down": nrm((DEPTH, N_EXPERTS, D_EXPERT, D), D_EXPERT ** -0.5),
        "moe_b_down": nrm((DEPTH, N_EXPERTS, D), 0.02),
    }


def reference(x, c, ctx, c_ctx, norm1_g, norm2_g, mod_w, mod_b,
              mlstm_w_in, mlstm_conv_w, mlstm_gate_b, mlstm_out_norm_g, mlstm_w_out,
              attn_w_in, attn_q_norm_g, attn_k_norm_g, attn_w_out,
              gla_w_in, gla_alpha_w2, gla_alpha_b, gla_out_norm_g, gla_w_out,
              router_w, router_b, moe_w_gu, moe_b_gu, moe_w_down, moe_b_down):
    h_lat, h_ctx = x, ctx
    cond_lat = jax.nn.silu(c)
    cond_ctx = jax.nn.silu(c_ctx)[None]
    b_, n_lat, D = x.shape
    n_ctx = ctx.shape[1]
    for layer in range(DEPTH):
        last = layer == DEPTH - 1
        mod_l = jnp.split(cond_lat @ mod_w[layer] + mod_b[layer], 6, axis=-1)
        mod_c = jnp.split(cond_ctx @ mod_w[layer] + mod_b[layer], 6, axis=-1)
        u_lat = modulate(rms_norm(h_lat, norm1_g[layer]), mod_l[0], mod_l[1])
        u_ctx = modulate(rms_norm(h_ctx, norm1_g[layer]), mod_c[0], mod_c[1])
        kind, j = layer % N_MIXERS, layer // N_MIXERS
        if kind == 0:
            y_ctx, y_lat = mlstm_mixer(u_ctx, u_lat, mlstm_w_in[j], mlstm_conv_w[j], mlstm_gate_b[j],
                                       mlstm_out_norm_g[j], mlstm_w_out[j], not last)
        elif kind == 1:
            y_ctx, y_lat = gqa_mixer(u_ctx, u_lat, attn_w_in[j], attn_q_norm_g[j], attn_k_norm_g[j],
                                     attn_w_out[j], not last)
        else:
            y_ctx, y_lat = gla_mixer(u_ctx, u_lat, gla_w_in[j], gla_alpha_w2[j], gla_alpha_b[j],
                                     gla_out_norm_g[j], gla_w_out[j], not last)
        h_lat = h_lat + mod_l[2][:, None, :] * y_lat
        v_lat = modulate(rms_norm(h_lat, norm2_g[layer]), mod_l[3], mod_l[4])
        moe_args = (router_w[layer], router_b[layer], moe_w_gu[layer], moe_b_gu[layer],
                    moe_w_down[layer], moe_b_down[layer])
        if last:
            f_lat = moe(v_lat.reshape(-1, D), *moe_args).reshape(b_, n_lat, D)
        else:
            h_ctx = h_ctx + mod_c[2][:, None, :] * y_ctx
            v_ctx = modulate(rms_norm(h_ctx, norm2_g[layer]), mod_c[3], mod_c[4])
            tokens = jnp.concatenate([v_ctx.reshape(-1, D), v_lat.reshape(-1, D)], axis=0)
            f_all = moe(tokens, *moe_args)
            f_ctx = f_all[:b_ * n_ctx].reshape(b_, n_ctx, D)
            f_lat = f_all[b_ * n_ctx:].reshape(b_, n_lat, D)
            h_ctx = h_ctx + mod_c[5][:, None, :] * f_ctx
        h_lat = h_lat + mod_l[5][:, None, :] * f_lat
    return h_lat
```

```cpp
#include <hip/hip_runtime.h>
#include <cstdio>
#include <cstdint>
#include <cstddef>

#ifndef MK_MULTI
#define MK_MULTI 0
#endif

#define GAS __attribute__((address_space(1)))
#define LAS __attribute__((address_space(3)))
typedef unsigned short bf16_t;
typedef short bf16x8 __attribute__((ext_vector_type(8)));
typedef float f32x4 __attribute__((ext_vector_type(4)));
typedef float f32x2 __attribute__((ext_vector_type(2)));
typedef unsigned u32x4 __attribute__((ext_vector_type(4)));
typedef unsigned u32x2 __attribute__((ext_vector_type(2)));

constexpr int DM = 1024, NBATCH = 4, SEQ = 4096, CTXL = 256, DEPTH = 4;
constexpr int NCTXR = NBATCH * CTXL;
constexpr int NLATR = NBATCH * SEQ;
constexpr int NTOK = NCTXR + NLATR;
constexpr int NEXP = 32, TOPK = 4;
constexpr int NPAD_A = 3328, NPAD_B = 2048;
constexpr int MAXTILES = 304;
constexpr float NORM_EPS = 1e-6f;

constexpr size_t MiB = 1u << 20;
constexpr size_t WS_CTL = 0, CTL_ZERO_BYTES = 1 * MiB;
constexpr size_t WS_MODV = 1 * MiB;
constexpr size_t WS_ROUTW = 3 * MiB;
constexpr size_t WS_TOKREC = 4 * MiB;
constexpr size_t WS_SLOTTOK = 5 * MiB;
constexpr size_t WS_HCTX = 8 * MiB;
constexpr size_t WS_GATES = 360 * MiB;
constexpr size_t WS_WIN = 16 * MiB;
constexpr size_t WS_WOUT = 48 * MiB;
constexpr size_t WS_U = 64 * MiB;
constexpr size_t WS_P = 128 * MiB;
constexpr size_t WS_AUX = 240 * MiB;
constexpr size_t WS_HDIR = 400 * MiB;
constexpr size_t WS_DELTA = WS_HDIR;
constexpr size_t WS_YPRE = 480 * MiB;
constexpr size_t WS_HDN = 520 * MiB;
constexpr size_t WS_Y2 = 680 * MiB;
constexpr size_t WS_WGU = 1024 * MiB;
constexpr size_t WS_WD = 1536 * MiB;
constexpr size_t WS_END = 1792 * MiB;
constexpr size_t AUX_QK = 0;
constexpr size_t AUX_KB = 40 * MiB;
constexpr size_t AUX_VB = 60 * MiB;
constexpr size_t AUX_QT = 0;
constexpr size_t AUX_KT = 36 * MiB;
constexpr size_t AUX_KHT = 72 * MiB;
constexpr size_t AUX_DEC = 108 * MiB;
constexpr int CW_BAR = 4096;
constexpr int CW_CNT = 16384;
constexpr int CW_DEP = 32768;

constexpr int LDS_BYTES = 147456;
constexpr int TAB_OFF = 131072;
constexpr int MISC_OFF = LDS_BYTES - 16;

typedef __bf16 bf16x2_t __attribute__((ext_vector_type(2)));
__device__ __forceinline__ unsigned cvt_pk_bf16(float lo, float hi) { f32x2 v = {lo, hi}; bf16x2_t r = __builtin_convertvector(v, bf16x2_t); return __builtin_bit_cast(unsigned, r); }
__device__ __forceinline__ bf16_t f2bf(float f) { return (bf16_t)(cvt_pk_bf16(f, 0.f) & 0xffffu); }
__device__ __forceinline__ float bf2f(bf16_t b) { return __uint_as_float(((unsigned)b) << 16); }
__device__ __forceinline__ float bflo(unsigned w) { return __uint_as_float(w << 16); }
__device__ __forceinline__ float bfhi(unsigned w) { return __uint_as_float(w & 0xffff0000u); }
__device__ __forceinline__ float shx(float v, int mask, int lane) { return __int_as_float(__builtin_amdgcn_ds_bpermute((lane ^ mask) << 2, __float_as_int(v))); }
__device__ __forceinline__ int shxi(int v, int mask, int lane) { return __builtin_amdgcn_ds_bpermute((lane ^ mask) << 2, v); }
__device__ __forceinline__ float shup(float v, int d, int lane) { const int src = lane >= d ? lane - d : lane; return __int_as_float(__builtin_amdgcn_ds_bpermute(src << 2, __float_as_int(v))); }
__device__ __forceinline__ float shdn(float v, int d, int lane) { const int src = lane + d < 64 ? lane + d : lane; return __int_as_float(__builtin_amdgcn_ds_bpermute(src << 2, __float_as_int(v))); }
__device__ __forceinline__ float shidx(float v, int src) { return __int_as_float(__builtin_amdgcn_ds_bpermute(src << 2, __float_as_int(v))); }
template <int CTRL> __device__ __forceinline__ float dpp(float x) { return __builtin_bit_cast(float, __builtin_amdgcn_mov_dpp(__builtin_bit_cast(int, x), CTRL, 0xf, 0xf, true)); }
constexpr int DPP_XOR1 = 0xB1, DPP_XOR2 = 0x4E, DPP_XOR7 = 0x141, DPP_XOR8 = 0x128, DPP_ROR4 = 0x124, DPP_XOR3 = 0x1B;
__device__ __forceinline__ float row16_sum(float x) { x += dpp<DPP_XOR1>(x); x += dpp<DPP_XOR2>(x); x += dpp<DPP_ROR4>(x); x += dpp<DPP_XOR8>(x); return x; }
__device__ __forceinline__ float half_sum(float x) {
    x = row16_sum(x); auto s_ = __builtin_amdgcn_permlane16_swap(__float_as_uint(x), __float_as_uint(x), false, false); return __uint_as_float(s_[0]) + __uint_as_float(s_[1]); }
__device__ __forceinline__ float wave_sum(float x, int) {
    x = half_sum(x); auto t_ = __builtin_amdgcn_permlane32_swap(__float_as_uint(x), __float_as_uint(x), false, false); return __uint_as_float(t_[0]) + __uint_as_float(t_[1]); }
template <int M> __device__ __forceinline__ float xch(float x, int lane) {
    if constexpr (M == 1) return dpp<DPP_XOR1>(x);
    else if constexpr (M == 2) return dpp<DPP_XOR2>(x);
    else if constexpr (M == 4) return dpp<DPP_XOR3>(dpp<DPP_XOR7>(x));
    else if constexpr (M == 8) return dpp<DPP_XOR8>(x);
    else if constexpr (M == 16) { auto s_ = __builtin_amdgcn_permlane16_swap(__float_as_uint(x), __float_as_uint(x), false, false); return __uint_as_float((lane & 16) ? s_[0] : s_[1]); }
    else { auto s_ = __builtin_amdgcn_permlane32_swap(__float_as_uint(x), __float_as_uint(x), false, false); return __uint_as_float((lane & 32) ? s_[0] : s_[1]); }
}
__device__ __forceinline__ float sigmoidf_(float x) { return __builtin_amdgcn_rcpf(1.f + __builtin_amdgcn_exp2f(-1.4426950408889634f * x)); }
__device__ __forceinline__ float logsigmoidf_(float x) { return fminf(x, 0.f) - __logf(1.f + __expf(-fabsf(x))); }
#define LDS_WAIT() asm volatile("s_waitcnt lgkmcnt(0)" ::: "memory")
#define VM_WAIT() asm volatile("s_waitcnt vmcnt(0)" ::: "memory")

#define XB_TMO      128
#define XB_XCNT(j)  (256  + 64 * (j))
#define XB_XSUB(j)  (1280 + 64 * (j))
#define XB_XGEN(j)  (2304 + 64 * (j))
#define XB_TOP      3328
#define XB_TOPGEN   3392
#define XCD_BAR_WORDS 3456
#define XB_SPIN_CAP (1u << 18)

__device__ __forceinline__ unsigned xb_ld(unsigned* p)              { return __hip_atomic_load(p, __ATOMIC_RELAXED, __HIP_MEMORY_SCOPE_AGENT); }
__device__ __forceinline__ unsigned xb_add(unsigned* p, unsigned v) { return __hip_atomic_fetch_add(p, v, __ATOMIC_RELAXED, __HIP_MEMORY_SCOPE_AGENT); }
__device__ __forceinline__ unsigned xb_xcc_id() { return (unsigned)__builtin_amdgcn_s_getreg((3 << 11) | 20) & 0xFu; }
#define XB_SPIN(cond, bar) do { unsigned _sp = 0; while (cond) { __builtin_amdgcn_s_sleep(1); \
    if ((++_sp & 255u) == 0u) { if (xb_ld(&(bar)[XB_TMO])) break; if (_sp > XB_SPIN_CAP) { atomicAdd(&(bar)[XB_TMO], 1u); break; } } } } while (0)

struct XcdBarrier { unsigned* bar; unsigned x; volatile LAS unsigned* st; };

__device__ __forceinline__ XcdBarrier xcd_barrier_post(unsigned* bar, volatile LAS unsigned* st) {
    XcdBarrier b; b.bar = bar; b.x = xb_xcc_id(); b.st = st;
    if (threadIdx.x == 0) (void)xb_add(&bar[XB_XCNT(b.x)], 1u);
    return b;
}
__device__ __forceinline__ void xcd_barrier_complete(unsigned* bar, unsigned x, unsigned& nloc, unsigned& nx) {
    const unsigned G = gridDim.x * gridDim.y * gridDim.z;
    unsigned sum, cnt, mine, sp = 0u;
    for (;;) {
        sum = 0u; cnt = 0u; mine = 0u;
#pragma unroll
        for (unsigned j = 0; j < 16; ++j) { const unsigned c = xb_ld(&bar[XB_XCNT(j)]); sum += c; cnt += (c > 0u) ? 1u : 0u; mine = (j == x) ? c : mine; }
        if (sum == G) break;
        __builtin_amdgcn_s_sleep(1);
        if ((++sp & 255u) == 0u) { if (xb_ld(&bar[XB_TMO])) break; if (sp > XB_SPIN_CAP) { atomicAdd(&bar[XB_TMO], 1u); break; } }
    }
    nloc = mine > 0u ? mine : 1u; nx = cnt > 0u ? cnt : 1u;
}
__device__ __forceinline__ void xcd_barrier(const XcdBarrier& b) {
    asm volatile("s_waitcnt vmcnt(0)" ::: "memory");
    __syncthreads();
    if (threadIdx.x == 0) {
        unsigned* bar = b.bar;
        __builtin_amdgcn_s_waitcnt(0);
        unsigned nloc = b.st[0], nx = b.st[1];
        if (nloc == 0u) { xcd_barrier_complete(bar, b.x, nloc, nx); b.st[0] = nloc; b.st[1] = nx; }
        const unsigned old = xb_add(&bar[XB_XSUB(b.x)], 1u);
        const unsigned gen = old / nloc;
        if (old + 1u == (gen + 1u) * nloc) {
            __builtin_amdgcn_fence(__ATOMIC_RELEASE, "agent");
            asm volatile("s_waitcnt vmcnt(0)" ::: "memory");
            const unsigned og = xb_add(&bar[XB_TOP], 1u);
            const unsigned tg = og / nx;
            if (og + 1u == (tg + 1u) * nx) xb_add(&bar[XB_TOPGEN], 1u);
            else XB_SPIN(xb_ld(&bar[XB_TOPGEN]) == tg, bar);
            __builtin_amdgcn_fence(__ATOMIC_ACQUIRE, "agent");
            xb_add(&bar[XB_XGEN(b.x)], 1u);
            asm volatile("s_waitcnt vmcnt(0)" ::: "memory");
        } else {
            XB_SPIN(xb_ld(&bar[XB_XGEN(b.x)]) == gen, bar);
            __builtin_amdgcn_fence(__ATOMIC_ACQUIRE, "agent");
            asm volatile("s_waitcnt vmcnt(0)" ::: "memory");
        }
    }
    __syncthreads();
}

#define CAS __attribute__((address_space(4)))
typedef const float* cfp_t;
struct Args { const float* in[28]; float* out; unsigned char* ws; int ph_lo, ph_hi; };
static_assert(offsetof(Args, in) == 0 && offsetof(Args, out) == 224 && offsetof(Args, ws) == 232 && offsetof(Args, ph_lo) == 240 && sizeof(Args) == 248, "Args layout (the kernel reads the kernarg segment by offset)");
struct Frame {
    LAS unsigned char* lds;
    int tid, lane, wave, G, bid;
    const CAS char* ka; GAS float* out_; GAS unsigned char* ws_;
};
enum { I_X = 0, I_C, I_CTX, I_CCTX, I_N1G, I_N2G, I_MODW, I_MODB, I_MWIN, I_MCONV, I_MGB, I_MNG, I_MWOUT, I_AWIN, I_AQG, I_AKG, I_AWOUT,
       I_GWIN, I_GAW2, I_GAB, I_GNG, I_GWOUT, I_RW, I_RB, I_WGU, I_BGU, I_WD, I_BD };

#define INP(F, k) ((const float*)(((const GAS float* const CAS*)(F).ka)[k]))
#define WSP(F) ((unsigned char*)(F).ws_)
#define OUTP(F) ((float*)(F).out_)
__device__ __forceinline__ Frame refresh(const Frame& F0) {
    Frame L = F0; int t = F0.tid; asm volatile("" : "+v"(t)); L.tid = t; L.lane = t & 63; L.wave = __builtin_amdgcn_readfirstlane(t >> 6);
    return L;
}

namespace g8 {
constexpr int BM = 256, BK = 64, HALF = 128, HTB = HALF * BK * 2, STAGE_BYTES = 8 * HTB, NXCD = 8, WGM = 8;
constexpr int K = 1024;
constexpr unsigned HSTEP = (unsigned)HALF * K * 2;
constexpr size_t TSTEP = 2 * (size_t)HSTEP;

__device__ __forceinline__ int lds_byte(int r, int c) { const int st = (r >> 4) * 2 + (c >> 5), rr = r & 15, cc = c & 31, ob = rr * 64 + cc * 2; return st * 1024 + (ob ^ (((ob >> 9) & 1) << 5)); }
__device__ __forceinline__ void stage_rc(int b, int& R, int& C) { const int st = b / 1024, sb = b % 1024, swz = sb ^ (((sb >> 9) & 1) << 5); R = (st >> 1) * 16 + swz / 64; C = (st & 1) * 32 + (swz % 64) / 2; }
__device__ __forceinline__ int perm32(int rho) { const int n = rho >> 4, i = rho & 15; return 8 * (i >> 2) + 4 * n + (i & 3); }

struct Unit { const char* a; const char* b0; const char* b1; int orow; int ocol; int e; int aux; };

struct StaticSched {
    const char* A; const char* Bt; int nM, nN, nwg, G, c, row_off;
    __device__ __forceinline__ void init(const void* A_, const void* Bt_, int M, int N, int G_, int c_, int row_off_ = 0) { A = (const char*)A_ + (size_t)row_off_ * (K * 2); Bt = (const char*)Bt_; nM = M / BM; nN = N / BM; nwg = nM * nN; G = G_; c = c_; row_off = row_off_; }
    __device__ __forceinline__ bool next(int i, Unit& u) const {
        const long L = (long)i * G + c; if (L >= nwg) return false;
        int wgid = (int)L; { const int q = nwg / NXCD, r = nwg % NXCD, xcd = wgid % NXCD, off = wgid / NXCD; wgid = (xcd < r ? xcd * (q + 1) : r * (q + 1) + (xcd - r) * q) + off; }
        const int nig = WGM * nN, gid = wgid / nig, fm = gid * WGM, gsz = (nM - fm) < WGM ? (nM - fm) : WGM;
        const int pm = fm + ((wgid % nig) % gsz), pn = (wgid % nig) / gsz;
        u.a = A + (size_t)pm * TSTEP; u.b0 = Bt + (size_t)pn * TSTEP; u.b1 = u.b0 + HSTEP; u.orow = row_off + pm * BM; u.ocol = pn * BM; u.e = 0; u.aux = 0; return true;
    }
    static constexpr bool GATHER = false, DEP = false;
    __device__ __forceinline__ void a_rows(const Unit&, const unsigned (&)[2], unsigned (&)[2]) const {}
};
template <bool GU> struct MoeSched {
    const char* A; const char* W; const int* slottok; const LAS int* tab; int nunits, G, c; const unsigned* dep;
    static constexpr int NPN = GU ? 8 : 4;
    __device__ __forceinline__ bool next(int i, Unit& u) const {
        constexpr int TL = 32 / NPN;
        const int x = GU ? (c & 7) : 7 - (c & 7), j = c >> 3, T = (i * 8 + x) * TL + j / NPN, pn = j % NPN;
        if (T * NPN >= nunits) return false;
        const int e = __builtin_amdgcn_readfirstlane(tab[80 + T]);
        u.e = e; u.orow = T * BM; u.ocol = pn; u.aux = (T - __builtin_amdgcn_readfirstlane(tab[32 + e])) * BM;
        if (GU) { u.a = A; u.b0 = W + (size_t)e * (2048u * 2048u) + (size_t)pn * HSTEP; u.b1 = u.b0 + (size_t)1024 * 2048; }
        else { u.a = A + (size_t)T * TSTEP; u.b0 = W + (size_t)e * (1024u * 2048u) + (size_t)pn * TSTEP; u.b1 = u.b0 + HSTEP; }
        return true;
    }
    static constexpr bool GATHER = GU, DEP = !GU;
    __device__ __forceinline__ unsigned dep_load(const Unit& u) const { return __hip_atomic_load(dep + (u.orow >> 8), __ATOMIC_RELAXED, __HIP_MEMORY_SCOPE_AGENT); }
    __device__ __forceinline__ void a_rows(const Unit& u, const unsigned (&sv)[2], unsigned (&tk)[2]) const {
        const int cnt = __builtin_amdgcn_readfirstlane(tab[u.e]);
#pragma unroll
        for (int h = 0; h < 2; ++h) {
            const int s0 = u.aux + h * HALF + (int)(sv[0] >> 11), s1 = u.aux + h * HALF + (int)(sv[1] >> 11);
            const int t0 = (s0 < cnt) ? slottok[u.e * NTOK + s0] : 0, t1 = (s1 < cnt) ? slottok[u.e * NTOK + s1] : 0;
            tk[h] = (unsigned)t0 | ((unsigned)t1 << 16);
        }
    }
};

struct EpiBf16 {
    static constexpr bool PERM = true, PRE = false, PUB = false;
    bf16_t* O; int ldc;
    __device__ __forceinline__ void operator()(const f32x4 (&acc)[2][2][4][2], const Unit& u, int wr, int wc, int fr, int fq) const {
        const int row0 = u.orow + wr * 64 + fr, col0 = u.ocol + wc * 32 + 8 * fq;
#pragma unroll
        for (int ai = 0; ai < 2; ++ai)
#pragma unroll
            for (int m = 0; m < 4; ++m) { bf16_t* rowp = O + (size_t)(row0 + ai * HALF + m * 16) * ldc + col0;
#pragma unroll
                for (int bj = 0; bj < 2; ++bj) { const f32x4 v0 = acc[ai][bj][m][0], v1 = acc[ai][bj][m][1];
                    u32x4 w; w.x = cvt_pk_bf16(v0[0], v0[1]); w.y = cvt_pk_bf16(v0[2], v0[3]); w.z = cvt_pk_bf16(v1[0], v1[1]); w.w = cvt_pk_bf16(v1[2], v1[3]);
                    *(u32x4*)(rowp + bj * HALF) = w; } }
    }
};
struct EpiDelta {
    static constexpr bool PERM = true, PRE = true, PUB = false;
    bf16_t* O; const float* mod2;
    __device__ __forceinline__ void prefetch(const Unit& u, LAS unsigned char* aux, int lane) const {
        const int r = u.orow < NCTXR ? 4 : ((u.orow - NCTXR) >> 12);
        __builtin_amdgcn_global_load_lds((const unsigned*)(mod2 + r * 6144 + u.ocol + lane * 4), (LAS unsigned*)aux, 16, 0, 0);
    }
    __device__ __forceinline__ void operator()(const f32x4 (&acc)[2][2][4][2], const Unit& u, int wr, int wc, int fr, int fq, const LAS unsigned char* aux) const {
        const int row0 = u.orow + wr * 64 + fr, cu = wc * 32 + 8 * fq, col0 = u.ocol + cu;
        f32x4 mv[2][2];
#pragma unroll
        for (int bj = 0; bj < 2; ++bj)
#pragma unroll
            for (int n = 0; n < 2; ++n) mv[bj][n] = *(const LAS f32x4*)(aux + (bj * HALF + cu + 4 * n) * 4);
#pragma unroll
        for (int ai = 0; ai < 2; ++ai)
#pragma unroll
            for (int m = 0; m < 4; ++m) { bf16_t* rowp = O + (size_t)(row0 + ai * HALF + m * 16) * DM + col0;
#pragma unroll
                for (int bj = 0; bj < 2; ++bj) { const f32x4 v0 = acc[ai][bj][m][0] * mv[bj][0], v1 = acc[ai][bj][m][1] * mv[bj][1];
                    u32x4 w; w.x = cvt_pk_bf16(v0[0], v0[1]); w.y = cvt_pk_bf16(v0[2], v0[3]); w.z = cvt_pk_bf16(v1[0], v1[1]); w.w = cvt_pk_bf16(v1[2], v1[3]);
                    *(u32x4*)(rowp + bj * HALF) = w; } }
    }
};
struct EpiSwiglu {
    static constexpr bool PERM = true, PRE = true, PUB = true;
    bf16_t* H; const float* bgu; unsigned* dep;
    __device__ __forceinline__ void publish(int orow) const { __hip_atomic_fetch_add(dep + (orow >> 8), 1u, __ATOMIC_RELAXED, __HIP_MEMORY_SCOPE_AGENT); }
    __device__ __forceinline__ void prefetch(const Unit& u, LAS unsigned char* aux, int lane) const {
        const float* g = bgu + u.e * 2048 + u.ocol * 128 + (lane >> 5) * 1024 + (lane & 31) * 4;
        __builtin_amdgcn_global_load_lds((const unsigned*)g, (LAS unsigned*)aux, 16, 0, 0);
    }
    __device__ __forceinline__ void operator()(const f32x4 (&acc)[2][2][4][2], const Unit& u, int wr, int wc, int fr, int fq, const LAS unsigned char* aux) const {
        const int row0 = u.orow + wr * 64 + fr, cl = wc * 32 + 8 * fq, col0 = u.ocol * 128 + cl;
        f32x4 bg[2], bl[2];
        const __amdgpu_buffer_rsrc_t rs = __builtin_amdgcn_make_buffer_rsrc(H, 0, (int)(160u * 1024u * 1024u), 0x00020000);
#pragma unroll
        for (int n = 0; n < 2; ++n) { bg[n] = *(const LAS f32x4*)(aux + (cl + 4 * n) * 4); bl[n] = *(const LAS f32x4*)(aux + 512 + (cl + 4 * n) * 4); }
#pragma unroll
        for (int ai = 0; ai < 2; ++ai)
#pragma unroll
            for (int m = 0; m < 4; ++m) {
                float o[8];
#pragma unroll
                for (int n = 0; n < 2; ++n) { const f32x4 gv = acc[ai][0][m][n] + bg[n], lv = acc[ai][1][m][n] + bl[n];
#pragma unroll
                    for (int j = 0; j < 4; ++j) { const float g = fminf(gv[j], 7.f), li = fminf(fmaxf(lv[j], -7.f), 7.f);
                        o[n * 4 + j] = g * (li + 1.f) * __builtin_amdgcn_rcpf(1.f + __builtin_amdgcn_exp2f(-2.4554669595930156f * g)); } }
                u32x4 w; w.x = cvt_pk_bf16(o[0], o[1]); w.y = cvt_pk_bf16(o[2], o[3]); w.z = cvt_pk_bf16(o[4], o[5]); w.w = cvt_pk_bf16(o[6], o[7]);
                __builtin_amdgcn_raw_buffer_store_b128(w, rs, (unsigned)(((row0 + ai * HALF + m * 16) * DM + col0) * 2), 0,   16); }
    }
};
struct EpiDown {
    static constexpr bool PERM = true, PRE = true, PUB = false;
    bf16_t* Y; const float* bd;
    __device__ __forceinline__ void prefetch(const Unit& u, LAS unsigned char* aux, int lane) const {
        __builtin_amdgcn_global_load_lds((const unsigned*)(bd + u.e * 1024 + u.ocol * 256 + lane * 4), (LAS unsigned*)aux, 16, 0, 0);
    }
    __device__ __forceinline__ void operator()(const f32x4 (&acc)[2][2][4][2], const Unit& u, int wr, int wc, int fr, int fq, const LAS unsigned char* aux) const {
        const int row0 = u.orow + wr * 64 + fr, cu = wc * 32 + 8 * fq, col0 = u.ocol * 256 + cu;
        f32x4 bv[2][2];
#pragma unroll
        for (int bj = 0; bj < 2; ++bj)
#pragma unroll
            for (int n = 0; n < 2; ++n) bv[bj][n] = *(const LAS f32x4*)(aux + (bj * HALF + cu + 4 * n) * 4);
#pragma unroll
        for (int ai = 0; ai < 2; ++ai)
#pragma unroll
            for (int m = 0; m < 4; ++m) { bf16_t* rowp = Y + (size_t)(row0 + ai * HALF + m * 16) * DM + col0;
#pragma unroll
                for (int bj = 0; bj < 2; ++bj) { const f32x4 v0 = acc[ai][bj][m][0] + bv[bj][0], v1 = acc[ai][bj][m][1] + bv[bj][1];
                    u32x4 w; w.x = cvt_pk_bf16(v0[0], v0[1]); w.y = cvt_pk_bf16(v0[2], v0[3]); w.z = cvt_pk_bf16(v1[0], v1[1]); w.w = cvt_pk_bf16(v1[2], v1[3]);
                    *(u32x4*)(rowp + bj * HALF) = w; } }
    }
};

template <class Epi, class Sched>
__device__ __forceinline__ void gemm_phase(LAS unsigned char* lds, const Sched& S, const Epi& E) {
    int tz = threadIdx.x; asm volatile("" : "+v"(tz));
    const int tid = tz, wid = __builtin_amdgcn_readfirstlane(tid >> 6), lane = tid & 63, wr = wid >> 2, wc = wid & 3, fr = lane & 15, fq = lane >> 4;
    constexpr int nt = K / BK;
    constexpr bool GATHER = Sched::GATHER;
    unsigned svA[2], voffB[2];
#pragma unroll
    for (int i = 0; i < 2; ++i) { int R, C; stage_rc(tid * 16 + i * 8192, R, C); const int Rb = Epi::PERM ? ((R & ~31) + perm32(R & 31)) : R;
        svA[i] = (unsigned)(R * K + C) * 2u; voffB[i] = (unsigned)(Rb * K + C) * 2u; }
    constexpr size_t kstep = (size_t)(BK * 2);
    const unsigned ldsw = (unsigned)wid * 1024u;
    const int aoff = lds_byte(wr * 64 + fr, fq * 8), boff = lds_byte(wc * 32 + fr, fq * 8);
#define G8_SA(b, h) (((b) * 2 + (h)) * HTB)
#define G8_SB(b, h) ((4 + (b) * 2 + (h)) * HTB)
#define G8_STAGE2(bufoff, gbase, v0, v1) do { \
        __builtin_amdgcn_global_load_lds((const unsigned*)((const char*)(gbase) + (v0)), (LAS unsigned*)(lds + (bufoff) + ldsw), 16, 0, 0); \
        __builtin_amdgcn_global_load_lds((const unsigned*)((const char*)(gbase) + (v1)), (LAS unsigned*)(lds + (bufoff) + ldsw + 8192), 16, 0, 0); } while (0)
#define G8_STAGE_A(bufoff, gbase, h, tk) do { if constexpr (GATHER) { const unsigned _t = (tk)[h]; \
            G8_STAGE2(bufoff, gbase, (_t & 0xffffu) * 2048u + (svA[0] & 2047u), (_t >> 16) * 2048u + (svA[1] & 2047u)); } \
        else { G8_STAGE2(bufoff, (gbase) + (h) * HSTEP, svA[0], svA[1]); } } while (0)
#define G8_LDA(dst, b, h) do { _Pragma("unroll") for (int m = 0; m < 4; ++m) _Pragma("unroll") for (int k = 0; k < 2; ++k) dst[m][k] = *(const LAS bf16x8*)(lds + G8_SA(b, h) + aoff + m * 2048 + k * 1024); } while (0)
#define G8_LDB(dst, b, h) do { _Pragma("unroll") for (int n = 0; n < 2; ++n) _Pragma("unroll") for (int k = 0; k < 2; ++k) dst[n][k] = *(const LAS bf16x8*)(lds + G8_SB(b, h) + boff + n * 2048 + k * 1024); } while (0)
#define G8_MMA(ai, bj, At, Bt) do { __builtin_amdgcn_s_setprio(1); _Pragma("unroll") for (int m = 0; m < 4; ++m) _Pragma("unroll") for (int n = 0; n < 2; ++n) _Pragma("unroll") for (int k = 0; k < 2; ++k) \
        acc[ai][bj][m][n] = __builtin_amdgcn_mfma_f32_16x16x32_bf16(Bt[n][k], At[m][k], acc[ai][bj][m][n], 0, 0, 0); __builtin_amdgcn_s_setprio(0); } while (0)
#define G8_WAIT_V(n) asm volatile("s_waitcnt vmcnt(" #n ")" ::: "memory")
#define G8_WAIT_L(n) asm volatile("s_waitcnt lgkmcnt(" #n ")" ::: "memory")
#define G8_BAR __builtin_amdgcn_s_barrier()
#define G8_SCHED __builtin_amdgcn_sched_barrier(0)
    Unit cur, nxt; int ui = 0, prow = 0;
    if (!S.next(0, cur)) return;
    LAS unsigned char* const auxb = lds + (TAB_OFF + 2048);
    if constexpr (Sched::DEP) {
        if (wid == 0) { while (__builtin_amdgcn_readfirstlane(S.dep_load(cur)) < 8u) __builtin_amdgcn_s_sleep(2);
            __builtin_amdgcn_fence(__ATOMIC_ACQUIRE, "agent"); }
        G8_WAIT_V(0); G8_BAR;
    }
    if constexpr (Epi::PRE) { if (wid == 0) E.prefetch(cur, auxb, lane); }
    unsigned ctk[2] = {0u, 0u}, ntk[2] = {0u, 0u};
    if constexpr (GATHER) S.a_rows(cur, svA, ctk);
    f32x4 acc[2][2][4][2];
#pragma unroll
    for (int a = 0; a < 2; ++a)
#pragma unroll
        for (int b = 0; b < 2; ++b)
#pragma unroll
            for (int m = 0; m < 4; ++m)
#pragma unroll
                for (int n = 0; n < 2; ++n) acc[a][b][m][n] = (f32x4){0.f, 0.f, 0.f, 0.f};
    bf16x8 At[4][2], B0[2][2], B1[2][2];
    const char* cA = cur.a; const char* cB0 = cur.b0; const char* cB1 = cur.b1;
    G8_STAGE2(G8_SB(0, 0), cB0, voffB[0], voffB[1]); G8_STAGE_A(G8_SA(0, 0), cA, 0, ctk); G8_STAGE2(G8_SB(0, 1), cB1, voffB[0], voffB[1]); G8_STAGE_A(G8_SA(0, 1), cA, 1, ctk);
    if (wr == 1) G8_BAR;
    G8_WAIT_V(4); G8_BAR;
    G8_STAGE2(G8_SB(1, 0), cB0 + kstep, voffB[0], voffB[1]); G8_STAGE_A(G8_SA(1, 0), cA + kstep, 0, ctk); G8_STAGE2(G8_SB(1, 1), cB1 + kstep, voffB[0], voffB[1]);
    G8_WAIT_V(6); G8_BAR;
    for (;;) {
        const bool has_next = S.next(ui + 1, nxt);
        const char* nA = has_next ? nxt.a : cA; const char* nB0 = has_next ? nxt.b0 : cB0; const char* nB1 = has_next ? nxt.b1 : cB1;
        ntk[0] = ctk[0]; ntk[1] = ctk[1];
        unsigned dv = 8u;
        if constexpr (Sched::DEP) { if (has_next && wid == 0) dv = S.dep_load(nxt); }
        for (int t = 0; t < nt; t += 2) {
            const bool last = (t == nt - 2);
            if constexpr (Sched::DEP) { if (t == nt - 4 && has_next && wid == 0) {
                while (__builtin_amdgcn_readfirstlane(dv) < 8u) { __builtin_amdgcn_s_sleep(2); dv = S.dep_load(nxt); }
                asm volatile("buffer_inv sc1" ::: "memory"); } }
            if constexpr (GATHER) { if (t == nt - 4 && has_next) S.a_rows(nxt, svA, ntk); }
            const char* a1 = cA + (size_t)(t + 1) * kstep;
            const char* a2 = last ? nA : cA + (size_t)(t + 2) * kstep;
            const char* b20 = last ? nB0 : cB0 + (size_t)(t + 2) * kstep; const char* b21 = last ? nB1 : cB1 + (size_t)(t + 2) * kstep;
            const char* a3 = a2 + kstep; const char* b30 = b20 + kstep; const char* b31 = b21 + kstep;
            unsigned tk2[2]; tk2[0] = last ? ntk[0] : ctk[0]; tk2[1] = last ? ntk[1] : ctk[1];
            G8_LDB(B0, 0, 0); G8_SCHED; G8_LDA(At, 0, 0); G8_STAGE_A(G8_SA(1, 1), a1, 1, ctk);
            G8_WAIT_L(8); G8_BAR; G8_WAIT_L(0); G8_MMA(0, 0, At, B0); G8_BAR; G8_SCHED;
            G8_LDB(B1, 0, 1); G8_STAGE2(G8_SB(0, 0), b20, voffB[0], voffB[1]);
            G8_BAR; G8_WAIT_L(0); G8_MMA(0, 1, At, B1); G8_BAR;
            G8_LDA(At, 0, 1); G8_STAGE_A(G8_SA(0, 0), a2, 0, tk2);
            G8_BAR; G8_WAIT_L(0); G8_MMA(1, 0, At, B0); G8_BAR; G8_SCHED;
            G8_STAGE2(G8_SB(0, 1), b21, voffB[0], voffB[1]);
            G8_WAIT_V(6); G8_BAR;
            if constexpr (Epi::PUB) { if (t == 0 && ui > 0) { int t3 = threadIdx.x; asm volatile("" : "+v"(t3)); if (t3 == 256) E.publish(prow); } }
            G8_MMA(1, 1, At, B1); G8_BAR;
            G8_LDB(B0, 1, 0); G8_SCHED; G8_LDA(At, 1, 0); G8_STAGE_A(G8_SA(0, 1), a2, 1, tk2);
            G8_WAIT_L(8); G8_BAR; G8_WAIT_L(0); G8_MMA(0, 0, At, B0); G8_BAR; G8_SCHED;
            G8_LDB(B1, 1, 1); G8_STAGE2(G8_SB(1, 0), b30, voffB[0], voffB[1]);
            G8_BAR; G8_WAIT_L(0); G8_MMA(0, 1, At, B1); G8_BAR;
            G8_LDA(At, 1, 1); G8_STAGE_A(G8_SA(1, 0), a3, 0, tk2);
            G8_BAR; G8_WAIT_L(0); G8_MMA(1, 0, At, B0); G8_BAR; G8_SCHED;
            G8_STAGE2(G8_SB(1, 1), b31, voffB[0], voffB[1]);
            G8_WAIT_V(6); G8_BAR; G8_MMA(1, 1, At, B1); G8_BAR;
        }
        { int t2 = threadIdx.x; asm volatile("" : "+v"(t2)); const int l2 = t2 & 63;
          if constexpr (Epi::PRE) E(acc, cur, wr, wc, l2 & 15, l2 >> 4, auxb + (ui & 1) * 1024); else E(acc, cur, wr, wc, l2 & 15, l2 >> 4); }
        if (!has_next) break;
#pragma unroll
        for (int a = 0; a < 2; ++a)
#pragma unroll
            for (int b = 0; b < 2; ++b)
#pragma unroll
                for (int m = 0; m < 4; ++m)
#pragma unroll
                    for (int n = 0; n < 2; ++n) acc[a][b][m][n] = (f32x4){0.f, 0.f, 0.f, 0.f};
        prow = cur.orow; cur = nxt; cA = nA; cB0 = nB0; cB1 = nB1; ++ui;
        ctk[0] = ntk[0]; ctk[1] = ntk[1];
        if constexpr (Epi::PRE) { if (wid == 0) E.prefetch(cur, auxb + (ui & 1) * 1024, lane); }
    }
    G8_WAIT_V(0);
    if (wr == 0) G8_BAR;
    G8_BAR;
    if constexpr (Epi::PUB) { if (tid == 256) E.publish(cur.orow); }
#undef G8_SA
#undef G8_SB
#undef G8_STAGE2
#undef G8_STAGE_A
#undef G8_LDA
#undef G8_LDB
#undef G8_MMA
#undef G8_WAIT_V
#undef G8_WAIT_L
#undef G8_BAR
#undef G8_SCHED
}
}

__device__ __forceinline__ void tc_item(const float* W, int N, int Nvalid, bf16_t* WT, int k0, int n0, LAS float* scr, int lane) {
    const bool ok = (n0 + lane) < Nvalid;
    const float* src = W + (size_t)k0 * N + n0 + lane;
#pragma unroll 16
    for (int i = 0; i < 64; ++i) { const float v = ok ? src[(size_t)i * N] : 0.f; scr[i * 65 + lane] = v; }
    LDS_WAIT();
    const int c = lane & 7, nr = lane >> 3;
#pragma unroll
    for (int j = 0; j < 8; ++j) { const int n = nr + 8 * j; const LAS float* s = scr + (8 * c) * 65 + n;
        u32x4 o; o.x = cvt_pk_bf16(s[0], s[65]); o.y = cvt_pk_bf16(s[2 * 65], s[3 * 65]); o.z = cvt_pk_bf16(s[4 * 65], s[5 * 65]); o.w = cvt_pk_bf16(s[6 * 65], s[7 * 65]);
        *(u32x4*)(WT + (size_t)(n0 + n) * 1024 + k0 + 8 * c) = o; }
    LDS_WAIT();
}
struct ConvTile { const float* src; bf16_t* dst; int N; };
__device__ __forceinline__ void conv_load(const ConvTile& T, f32x4 (&r)[16], int lane) {
    const int kq = lane >> 4, nq = lane & 15;
    const float* p = T.src + (size_t)kq * T.N + nq * 4;
#pragma unroll
    for (int i = 0; i < 16; ++i) r[i] = __builtin_nontemporal_load((const f32x4*)(p + (size_t)(4 * i) * T.N));
}
__device__ __forceinline__ void conv_emit(const ConvTile& T, const f32x4 (&r)[16], LAS float* scr, int lane) {
    const int kq = lane >> 4, nq = lane & 15;
#pragma unroll
    for (int i = 0; i < 16; ++i) { LAS float* w = scr + (4 * i + kq) * 65 + nq * 4; w[0] = r[i].x; w[1] = r[i].y; w[2] = r[i].z; w[3] = r[i].w; }
    LDS_WAIT();
    const int c = lane & 7, nr = lane >> 3;
#pragma unroll
    for (int j = 0; j < 8; ++j) { const int n = nr + 8 * j; const LAS float* s = scr + (8 * c) * 65 + n;
        u32x4 o; o.x = cvt_pk_bf16(s[0], s[65]); o.y = cvt_pk_bf16(s[2 * 65], s[3 * 65]); o.z = cvt_pk_bf16(s[4 * 65], s[5 * 65]); o.w = cvt_pk_bf16(s[6 * 65], s[7 * 65]);
        __builtin_nontemporal_store(o, (u32x4*)(T.dst + (size_t)n * 1024 + 8 * c)); }
    LDS_WAIT();
}
__device__ __forceinline__ bool moe_conv_tile(const Frame& F, int l0, int it, int nitems, ConvTile& T) {
    if (it >= nitems) return false;
    const int l = l0 + it / 24576, r = it % 24576;
    if (r < 16384) { const int mi = l * 32 + (r >> 9), j = r & 511, kb = j >> 5, nb = j & 31;
        T.src = INP(F, I_WGU) + (size_t)mi * 1024 * 2048 + (size_t)(kb * 64) * 2048 + nb * 64; T.dst = (bf16_t*)(WSP(F) + WS_WGU) + (size_t)mi * 2048 * 1024 + (size_t)(nb * 64) * 1024 + kb * 64; T.N = 2048; }
    else { const int q = r - 16384, mi = l * 32 + (q >> 8), j = q & 255, kb = j >> 4, nb = j & 15;
        T.src = INP(F, I_WD) + (size_t)mi * 1024 * 1024 + (size_t)(kb * 64) * 1024 + nb * 64; T.dst = (bf16_t*)(WSP(F) + WS_WD) + (size_t)mi * 1024 * 1024 + (size_t)(nb * 64) * 1024 + kb * 64; T.N = 1024; }
    return true;
}
__device__ __forceinline__ void moe_convert(const Frame& F, int l0, int l1, int w, int nw) {
    LAS float* scr = (LAS float*)(F.lds + F.wave * 16640);
    const int nitems = (l1 - l0) * 24576;
    ConvTile Ta, Tb; f32x4 ra[16], rb[16];
    int it = w;
    bool va = moe_conv_tile(F, l0, it, nitems, Ta);
    if (va) conv_load(Ta, ra, F.lane);
    while (va) {
        const bool vb = moe_conv_tile(F, l0, it + nw, nitems, Tb);
        if (vb) conv_load(Tb, rb, F.lane);
        conv_emit(Ta, ra, scr, F.lane);
        if (!vb) break;
        it += 2 * nw;
        va = moe_conv_tile(F, l0, it, nitems, Ta);
        if (va) conv_load(Ta, ra, F.lane);
        conv_emit(Tb, rb, scr, F.lane);
    }
}
__device__ __forceinline__ void phase_p0(const Frame& F0) {
    Frame F = refresh(F0);
    {
        LAS float* cond = (LAS float*)F.lds; LAS float* red = cond + 5 * 1024;
        for (int i = F.tid; i < 5 * 1024; i += 512) { const int r = i >> 10, k = i & 1023; const float c = r < 4 ? INP(F, I_C)[r * 1024 + k] : INP(F, I_CCTX)[k]; cond[i] = c / (1.f + __expf(-c)); }
        __syncthreads();
        float* modv = (float*)(WSP(F) + WS_MODV);
        for (int it = F.bid; it < 384; it += F.G) {
            const int l = it / 96, n0 = (it % 96) * 64, k0 = F.wave * 128;
            const float* W = INP(F, I_MODW) + (size_t)l * 1024 * 6144 + (size_t)k0 * 6144 + n0 + F.lane;
            float a0 = 0.f, a1 = 0.f, a2 = 0.f, a3 = 0.f, a4 = 0.f;
#pragma unroll 8
            for (int k = 0; k < 128; ++k) { const float w = W[(size_t)k * 6144]; const LAS float* cp = cond + k0 + k;
                a0 += cp[0] * w; a1 += cp[1024] * w; a2 += cp[2048] * w; a3 += cp[3072] * w; a4 += cp[4096] * w; }
            LAS float* rp = red + F.wave * 320 + F.lane;
            rp[0] = a0; rp[64] = a1; rp[128] = a2; rp[192] = a3; rp[256] = a4;
            __syncthreads();
            if (F.tid < 320) { const int r = F.tid >> 6, ln = F.tid & 63; float s = 0.f;
#pragma unroll
                for (int w = 0; w < 8; ++w) s += red[w * 320 + r * 64 + ln];
                modv[(size_t)(l * 5 + r) * 6144 + n0 + ln] = s + INP(F, I_MODB)[l * 6144 + n0 + ln]; }
            __syncthreads();
        }
        __syncthreads();
    }
    {
        float* rw = (float*)(WSP(F) + WS_ROUTW);
        for (int idx = F.bid * 512 + F.tid; idx < 4 * 32 * 1024; idx += F.G * 512) { const int l = idx >> 15, rem = idx & 32767, k = rem >> 5, e = rem & 31;
            rw[(size_t)(l * 32 + e) * 1024 + k] = INP(F, I_RW)[idx]; }
    }
    {
        LAS float* scr = (LAS float*)(F.lds + F.wave * 16640);
        const int gw = F.bid * 8 + F.wave, NGW = F.G * 8;
        constexpr int I_A = 16 * 52, I_B = 16 * 32, I_O = 16 * 16, I_GU = 16 * 32, I_DN = 16 * 16;
        constexpr int E0 = I_A, E1 = 2 * I_A, E2 = E1 + I_B, E3 = E2 + I_A, E4 = E3 + 4 * I_O, E5 = E4 + 128 * I_GU, E6 = E5 + 128 * I_DN;
        bf16_t* win = (bf16_t*)(WSP(F) + WS_WIN);
        for (int it = gw; it < E4; it += NGW) {
            const float* W; bf16_t* WT; int N, Nv, nbn, j;
            if (it < E1) { const int q = it >= E0; j = it - q * I_A; W = INP(F, I_MWIN) + (size_t)q * 1024 * 3104; WT = win + (size_t)(q ? 3 : 0) * (7 * MiB / 2); N = 3104; Nv = 3104; nbn = 52; }
            else if (it < E2) { j = it - E1; W = INP(F, I_AWIN); WT = win + (size_t)1 * (7 * MiB / 2); N = 2048; Nv = 2048; nbn = 32; }
            else if (it < E3) { j = it - E2; W = INP(F, I_GWIN); WT = win + (size_t)2 * (7 * MiB / 2); N = 3104; Nv = 3104; nbn = 52; }
            else if (it < E4) { const int q = (it - E3) >> 8; j = (it - E3) & 255; N = 1024; Nv = 1024; nbn = 16;
                W = q == 0 ? INP(F, I_MWOUT) : q == 1 ? INP(F, I_AWOUT) : q == 2 ? INP(F, I_GWOUT) : INP(F, I_MWOUT) + (size_t)1024 * 1024;
                WT = (bf16_t*)(WSP(F) + WS_WOUT) + (size_t)q * 1024 * 1024; }
            else if (it < E5) { const int mi = (it - E4) >> 9; j = (it - E4) & 511; N = 2048; Nv = 2048; nbn = 32;
                W = INP(F, I_WGU) + (size_t)mi * 1024 * 2048; WT = (bf16_t*)(WSP(F) + WS_WGU) + (size_t)mi * 2048 * 1024; }
            else { const int mi = (it - E5) >> 8; j = (it - E5) & 255; N = 1024; Nv = 1024; nbn = 16;
                W = INP(F, I_WD) + (size_t)mi * 1024 * 1024; WT = (bf16_t*)(WSP(F) + WS_WD) + (size_t)mi * 1024 * 1024; }
            const int kb = j / nbn, nb = j % nbn;
            tc_item(W, N, Nv, WT, kb * 64, nb * 64, scr, F.lane);
        }
    }
}

__device__ __forceinline__ void moe_tstart_table(const Frame& F0, int l) {
    Frame F = refresh(F0);
    LAS int* tab = (LAS int*)(F.lds + TAB_OFF);
    if (F.tid < 64) {
        const unsigned* cnt = (const unsigned*)(WSP(F) + WS_CTL) + CW_CNT + l * 32;
        const int e = F.lane & 31;
        const int c = (int)__hip_atomic_load(cnt + e, __ATOMIC_RELAXED, __HIP_MEMORY_SCOPE_AGENT);
        const int nt = (c + 255) >> 8;
        int inc = nt;
#pragma unroll
        for (int d = 1; d < 32; d <<= 1) { const int t_ = __builtin_amdgcn_ds_bpermute((((F.lane & 31) >= d ? F.lane - d : F.lane)) << 2, inc); if ((F.lane & 31) >= d) inc += t_; }
        const int start = inc - nt;
        if (F.lane < 32) { tab[e] = c; tab[32 + e] = start; if (e == 31) tab[64] = inc;
#pragma nounroll
            for (int t = 0; t < nt; ++t) tab[80 + start + t] = e; }
    }
    __syncthreads();
}
__device__ __forceinline__ void phase_a(const Frame& F0, int l) {
    Frame F = refresh(F0);
    const LAS int* tab = (const LAS int*)(F.lds + TAB_OFF);
    if (l > 0) moe_tstart_table(F, l - 1);
    const int gw = F.bid * 8 + F.wave, NGW = F.G * 8;
    const float* modv = (const float*)(WSP(F) + WS_MODV);
    const bf16_t* Y2 = (const bf16_t*)(WSP(F) + WS_Y2);
    const int2* tokrec = (const int2*)(WSP(F) + WS_TOKREC);
    float* hctx = (float*)(WSP(F) + WS_HCTX);
    bf16_t* U = (bf16_t*)(WSP(F) + WS_U);
    constexpr int NR = 2;
    for (int row0 = (l == 4 ? NCTXR : 0) + gw; row0 < NTOK; row0 += NR * NGW) {
        int row[NR]; bool ok[NR]; int rr[NR]; float* hp[NR]; f32x4 v[NR][4]; int2 rc[NR][4];
#pragma unroll
        for (int q = 0; q < NR; ++q) { row[q] = row0 + q * NGW; ok[q] = row[q] < NTOK; if (!ok[q]) row[q] = row0;
            const bool isctx = row[q] < NCTXR; rr[q] = isctx ? 4 : ((row[q] - NCTXR) >> 12);
            hp[q] = isctx ? hctx + (size_t)row[q] * DM : OUTP(F) + (size_t)(row[q] - NCTXR) * DM;
            const float* src = (l == 0) ? (isctx ? INP(F, I_CTX) + (size_t)row[q] * DM : INP(F, I_X) + (size_t)(row[q] - NCTXR) * DM) : hp[q];
#pragma unroll
            for (int j = 0; j < 4; ++j) v[q][j] = *((const f32x4*)src + F.lane + 64 * j);
            if (l > 0) {
#pragma unroll
                for (int k = 0; k < 4; ++k) rc[q][k] = tokrec[row[q] * 4 + k]; } }
        if (l > 0) {
            u32x2 yw[NR][4][4], dw[NR][4];
            const bf16_t* DELTA = (const bf16_t*)(WSP(F) + WS_DELTA);
#pragma unroll
            for (int q = 0; q < NR; ++q)
#pragma unroll
                for (int j = 0; j < 4; ++j) dw[q][j] = *((const u32x2*)(DELTA + (size_t)row[q] * DM) + F.lane + 64 * j);
#pragma unroll
            for (int q = 0; q < NR; ++q)
#pragma unroll
                for (int k = 0; k < 4; ++k) { const int e = rc[q][k].x >> 15, pos = rc[q][k].x & 32767;
                    const bf16_t* yp = Y2 + (size_t)(tab[32 + e] * 256 + pos) * DM;
#pragma unroll
                    for (int j = 0; j < 4; ++j) yw[q][k][j] = *((const u32x2*)yp + F.lane + 64 * j); }
#pragma unroll
            for (int q = 0; q < NR; ++q) {
                const float* m5 = modv + (size_t)((l - 1) * 5 + rr[q]) * 6144 + 5 * 1024;
#pragma unroll
                for (int j = 0; j < 4; ++j) { f32x4 acc = (f32x4){0.f, 0.f, 0.f, 0.f};
#pragma unroll
                    for (int k = 0; k < 4; ++k) { const u32x2 w = yw[q][k][j]; acc += __int_as_float(rc[q][k].y) * (f32x4){bflo(w.x), bfhi(w.x), bflo(w.y), bfhi(w.y)}; }
                    v[q][j] += (f32x4){bflo(dw[q][j].x), bfhi(dw[q][j].x), bflo(dw[q][j].y), bfhi(dw[q][j].y)} + *((const f32x4*)m5 + F.lane + 64 * j) * acc; } }
        }
#pragma unroll
        for (int q = 0; q < NR; ++q) {
            if (!ok[q]) continue;
#pragma unroll
            for (int j = 0; j < 4; ++j) *((f32x4*)hp[q] + F.lane + 64 * j) = v[q][j];
        }
        if (l < 4) {
            float ss[NR];
#pragma unroll
            for (int q = 0; q < NR; ++q) { ss[q] = 0.f;
#pragma unroll
                for (int j = 0; j < 4; ++j) ss[q] += (v[q][j].x * v[q][j].x + v[q][j].y * v[q][j].y) + (v[q][j].z * v[q][j].z + v[q][j].w * v[q][j].w); }
#pragma unroll
        for (int q = 0; q < NR; ++q) ss[q] = wave_sum(ss[q], F.lane);
            const float* g1 = INP(F, I_N1G) + l * DM;
#pragma unroll
            for (int q = 0; q < NR; ++q) {
                if (!ok[q]) continue;
                const float rstd = rsqrtf(ss[q] * (1.f / DM) + NORM_EPS);
                const float* m0 = modv + (size_t)(l * 5 + rr[q]) * 6144; const float* m1 = m0 + 1024;
#pragma unroll
                for (int j = 0; j < 4; ++j) { const f32x4 g = *((const f32x4*)g1 + F.lane + 64 * j), sh = *((const f32x4*)m0 + F.lane + 64 * j), sc = *((const f32x4*)m1 + F.lane + 64 * j);
                    const f32x4 u = v[q][j] * rstd * g * (sc + 1.f) + sh;
                    u32x2 w; w.x = cvt_pk_bf16(u.x, u.y); w.y = cvt_pk_bf16(u.z, u.w);
                    *((u32x2*)(U + (size_t)row[q] * DM) + F.lane + 64 * j) = w; }
            }
        }
    }
}

__device__ __forceinline__ void route_row(float (&p)[8], float rb, int lane, bool ok, int lr, LAS float* lg) {
    const int hi16 = (lane >> 4) & 1, hi8 = (lane >> 3) & 1, hi4 = (lane >> 2) & 1;
#pragma unroll
    for (int i = 0; i < 4; ++i) { const float send = hi16 ? p[i] : p[i + 4], keep = hi16 ? p[i + 4] : p[i]; p[i] = keep + xch<16>(send, lane); }
#pragma unroll
    for (int i = 0; i < 2; ++i) { const float send = hi8 ? p[i] : p[i + 2], keep = hi8 ? p[i + 2] : p[i]; p[i] = keep + xch<8>(send, lane); }
    { const float send = hi4 ? p[0] : p[1], keep = hi4 ? p[1] : p[0]; p[0] = keep + xch<4>(send, lane); }
    const float val = p[0] + xch<32>(p[0], lane) + rb;
    if (lane < 32 && ok) lg[lr * 33 + lane] = val;
}
__device__ __forceinline__ void phase_e(const Frame& F0, int l) {
    Frame F = refresh(F0);
    LAS f32x4* wr4 = (LAS f32x4*)F.lds;
    LAS int* cntl = (LAS int*)(F.lds + TAB_OFF);
    LAS int* basel = cntl + 32;
    LAS int* recs = cntl + 64;
    LAS float* lg = (LAS float*)(recs + 272 * 4);
    static_assert(TAB_OFF + 256 + 272 * 16 + 68 * 33 * 4 <= MISC_OFF, "phase E LDS map");
    const bool lastl = (l == DEPTH - 1);
    { const f32x4* src = (const f32x4*)((const float*)(WSP(F) + WS_ROUTW) + (size_t)l * 32 * 1024);
      for (int i = F.tid; i < 8192; i += 512) wr4[i] = src[i];
      if (F.tid < 32) cntl[F.tid] = 0; }
    __syncthreads();
    const float* modv = (const float*)(WSP(F) + WS_MODV);
    const float* hctx = (const float*)(WSP(F) + WS_HCTX);
    bf16_t* U = (bf16_t*)(WSP(F) + WS_U);
    constexpr int RPB = NTOK / 256;
    const float rb = INP(F, I_RB)[l * 32 + (F.lane & 31)];
    const float* g2 = INP(F, I_N2G) + l * DM;
    const bf16_t* DELTA = (const bf16_t*)(WSP(F) + WS_DELTA);
#pragma nounroll
    for (int lr0 = F.wave; lr0 < RPB; lr0 += 8 * 3) {
        constexpr int NR = 3;
        int lrq[NR], row[NR]; bool ok[NR]; f32x4 v[NR][4]; float ss[NR];
#pragma unroll
        for (int q = 0; q < NR; ++q) { lrq[q] = lr0 + 8 * q; ok[q] = lrq[q] < RPB; if (!ok[q]) lrq[q] = lr0; row[q] = F.bid * RPB + lrq[q];
            const bool isctx = row[q] < NCTXR;
            const float* hp = isctx ? hctx + (size_t)row[q] * DM : OUTP(F) + (size_t)(row[q] - NCTXR) * DM;
            ss[q] = 0.f;
#pragma unroll
            for (int j = 0; j < 4; ++j) { const u32x2 dw = *((const u32x2*)(DELTA + (size_t)row[q] * DM) + F.lane + 64 * j);
                v[q][j] = *((const f32x4*)hp + F.lane + 64 * j) + (f32x4){bflo(dw.x), bfhi(dw.x), bflo(dw.y), bfhi(dw.y)}; ss[q] += (v[q][j].x * v[q][j].x + v[q][j].y * v[q][j].y) + (v[q][j].z * v[q][j].z + v[q][j].w * v[q][j].w); } }
#pragma unroll
        for (int q = 0; q < NR; ++q) ss[q] = wave_sum(ss[q], F.lane);
#pragma unroll
        for (int q = 0; q < NR; ++q) {
            const int r = row[q] < NCTXR ? 4 : ((row[q] - NCTXR) >> 12);
            const float rstd = rsqrtf(ss[q] * (1.f / DM) + NORM_EPS);
            const float* m3 = modv + (size_t)(l * 5 + r) * 6144 + 3 * 1024; const float* m4 = m3 + 1024;
#pragma unroll
            for (int j = 0; j < 4; ++j) { const f32x4 g = *((const f32x4*)g2 + F.lane + 64 * j), sh = *((const f32x4*)m3 + F.lane + 64 * j), sc = *((const f32x4*)m4 + F.lane + 64 * j);
                v[q][j] = v[q][j] * rstd * g * (sc + 1.f) + sh;
                u32x2 w; w.x = cvt_pk_bf16(v[q][j].x, v[q][j].y); w.y = cvt_pk_bf16(v[q][j].z, v[q][j].w);
                if (ok[q]) *((u32x2*)(U + (size_t)row[q] * DM) + F.lane + 64 * j) = w; } }
        float pg[NR][8];
        int woff = F.lane; asm volatile("" : "+v"(woff));
        const int hb1 = F.lane & 1, hb2 = (F.lane >> 1) & 1;
#pragma unroll
        for (int g = 0; g < 8; ++g) {
            float sg[NR][4];
#pragma unroll
            for (int i = 0; i < 4; ++i) { f32x2 a2[NR];
#pragma unroll
                for (int q = 0; q < NR; ++q) a2[q] = (f32x2){0.f, 0.f};
#pragma unroll
                for (int j = 0; j < 4; ++j) { const f32x4 w = wr4[(4 * g + i) * 256 + j * 64 + woff];
                    const f32x2 wl = (f32x2){w.x, w.y}, wh = (f32x2){w.z, w.w};
#pragma unroll
                    for (int q = 0; q < NR; ++q) { a2[q] = __builtin_elementwise_fma((f32x2){v[q][j].x, v[q][j].y}, wl, a2[q]); a2[q] = __builtin_elementwise_fma((f32x2){v[q][j].z, v[q][j].w}, wh, a2[q]); } }
#pragma unroll
                for (int q = 0; q < NR; ++q) sg[q][i] = a2[q].x + a2[q].y; }
#pragma unroll
            for (int q = 0; q < NR; ++q) {
                const float t0 = (hb1 ? sg[q][1] : sg[q][0]) + xch<1>(hb1 ? sg[q][0] : sg[q][1], F.lane);
                const float t1 = (hb1 ? sg[q][3] : sg[q][2]) + xch<1>(hb1 ? sg[q][2] : sg[q][3], F.lane);
                pg[q][g] = (hb2 ? t1 : t0) + xch<2>(hb2 ? t0 : t1, F.lane); }
        }
#pragma unroll
        for (int q = 0; q < NR; ++q) route_row(pg[q], rb, F.lane, ok[q], lrq[q], lg);
    }
    __syncthreads();
    int nrec = 0;
    if (F.tid < RPB) {
        const int lr = F.tid, row = F.bid * RPB + lr;
        if (!(lastl && row < NCTXR)) {
            float v0 = -3.0e38f, v1 = -3.0e38f, v2 = -3.0e38f, v3 = -3.0e38f; int i0 = 0, i1 = 0, i2 = 0, i3 = 0;
            for (int e = 0; e < 32; ++e) { float t = lg[lr * 33 + e]; int ti = e;
                if (t > v0) { const float a = v0; v0 = t; t = a; const int b = i0; i0 = ti; ti = b; }
                if (t > v1) { const float a = v1; v1 = t; t = a; const int b = i1; i1 = ti; ti = b; }
                if (t > v2) { const float a = v2; v2 = t; t = a; const int b = i2; i2 = ti; ti = b; }
                if (t > v3) { v3 = t; i3 = ti; } }
            const float e1 = __expf(v1 - v0), e2 = __expf(v2 - v0), e3 = __expf(v3 - v0);
            const float inv = 1.f / (1.f + e1 + e2 + e3);
            const float gk[4] = {inv, e1 * inv, e2 * inv, e3 * inv}; const int te[4] = {i0, i1, i2, i3};
#pragma unroll
            for (int k = 0; k < 4; ++k) { const int lp = atomicAdd((int*)(cntl + te[k]), 1); LAS int* rp = recs + (lr * 4 + k) * 4; rp[0] = row; rp[1] = te[k]; rp[2] = lp; rp[3] = __float_as_int(gk[k]); }
            nrec = 1;
        } else { recs[(lr * 4) * 4] = -1; recs[(lr * 4 + 1) * 4] = -1; recs[(lr * 4 + 2) * 4] = -1; recs[(lr * 4 + 3) * 4] = -1; }
    }
    (void)nrec;
    __syncthreads();
    if (F.tid < 32) { unsigned* cnt = (unsigned*)(WSP(F) + WS_CTL) + CW_CNT + l * 32; basel[F.tid] = (int)atomicAdd(cnt + F.tid, (unsigned)cntl[F.tid]); }
    __syncthreads();
    int* slottok = (int*)(WSP(F) + WS_SLOTTOK); int2* tokrec = (int2*)(WSP(F) + WS_TOKREC);
    for (int i = F.tid; i < RPB * 4; i += 512) { const LAS int* rp = recs + i * 4; const int row = rp[0]; if (row < 0) continue; const int e = rp[1], pos = basel[e] + rp[2];
        slottok[e * NTOK + pos] = row; tokrec[row * 4 + (i & 3)] = make_int2((e << 15) | pos, rp[3]); }
    __syncthreads();
}

__device__ __forceinline__ bf16x8 lds_frag(const LAS bf16_t* base, int ld, int row0, int k0, int fr, int fq) {
    return *(const LAS bf16x8*)(base + (row0 + fr) * ld + k0 + fq * 8);
}
#define MMA16(a, b, c) __builtin_amdgcn_mfma_f32_16x16x32_bf16(a, b, c, 0, 0, 0)

__device__ __forceinline__ int scan_row(int b, int dir, int p) {
    if (p < CTXL) return b * CTXL + (dir ? CTXL - 1 - p : p);
    const int pl = p - CTXL; return NCTXR + b * SEQ + (dir ? SEQ - 1 - pl : pl);
}
__device__ __forceinline__ void tri_tile(int id, int& ti, int& si) { ti = id >= 6 ? 3 : id >= 3 ? 2 : id >= 1 ? 1 : 0; si = id - (ti * (ti + 1)) / 2; }

__device__ __forceinline__ void phase_c1a(const Frame& F0, int jl) {
    Frame F = refresh(F0);
    const int gw = F.bid * 8 + F.wave, NGW = F.G * 8;
    const bf16_t* P = (const bf16_t*)(WSP(F) + WS_P);
    bf16_t* QK = (bf16_t*)(WSP(F) + WS_AUX + AUX_QK);
    const float* cw = INP(F, I_MCONV) + (size_t)jl * 3 * 1024;
    f32x4 w0[4], w1[4], w2[4];
#pragma unroll
    for (int j = 0; j < 4; ++j) { w0[j] = *((const f32x4*)cw + F.lane + 64 * j); w1[j] = *((const f32x4*)(cw + 1024) + F.lane + 64 * j); w2[j] = *((const f32x4*)(cw + 2048) + F.lane + 64 * j); }
    for (int row = gw; row < NTOK; row += NGW) {
        const bool isctx = row < NCTXR; const int t = isctx ? (row & (CTXL - 1)) : ((row - NCTXR) & (SEQ - 1)); const int tl = isctx ? CTXL - 1 : SEQ - 1;
        const bool hp = t > 0, hn = t < tl;
        const bf16_t* pr = P + (size_t)row * NPAD_A;
#pragma unroll
        for (int j = 0; j < 4; ++j) {
            const u32x2 c0 = *((const u32x2*)pr + F.lane + 64 * j);
            u32x2 cm = (u32x2){0u, 0u}, cp = (u32x2){0u, 0u};
            if (hp) cm = *((const u32x2*)(pr - NPAD_A) + F.lane + 64 * j);
            if (hn) cp = *((const u32x2*)(pr + NPAD_A) + F.lane + 64 * j);
            f32x4 x = w0[j] * (f32x4){bflo(cm.x), bfhi(cm.x), bflo(cm.y), bfhi(cm.y)} + w1[j] * (f32x4){bflo(c0.x), bfhi(c0.x), bflo(c0.y), bfhi(c0.y)}
                    + w2[j] * (f32x4){bflo(cp.x), bfhi(cp.x), bflo(cp.y), bfhi(cp.y)};
            const float sc = (j < 2) ? 0.125f : 1.f;
            x.x = sc * x.x / (1.f + __expf(-x.x)); x.y = sc * x.y / (1.f + __expf(-x.y)); x.z = sc * x.z / (1.f + __expf(-x.z)); x.w = sc * x.w / (1.f + __expf(-x.w));
            u32x2 w; w.x = cvt_pk_bf16(x.x, x.y); w.y = cvt_pk_bf16(x.z, x.w);
            *((u32x2*)(QK + (size_t)row * DM) + F.lane + 64 * j) = w;
        }
    }
    const float* gb = INP(F, I_MGB) + jl * 32;
    f32x4* G = (f32x4*)(WSP(F) + WS_GATES);
    for (int ch = gw; ch < NTOK / 64; ch += NGW) {
        const int row = ch * 64 + F.lane;
        const u32x4* gp = (const u32x4*)(P + (size_t)row * NPAD_A + 3072);
        unsigned gwd[16];
#pragma unroll
        for (int q = 0; q < 4; ++q) { const u32x4 w = gp[q]; gwd[q * 4] = w.x; gwd[q * 4 + 1] = w.y; gwd[q * 4 + 2] = w.z; gwd[q * 4 + 3] = w.w; }
#pragma unroll
        for (int h = 0; h < 8; ++h) {
            const float i_f = ((h & 1) ? bfhi(gwd[(0 + h) >> 1]) : bflo(gwd[(0 + h) >> 1])) + gb[h];
            const float f_f = ((h & 1) ? bfhi(gwd[(8 + h) >> 1]) : bflo(gwd[(8 + h) >> 1])) + gb[8 + h];
            const float i_b = ((h & 1) ? bfhi(gwd[(16 + h) >> 1]) : bflo(gwd[(16 + h) >> 1])) + gb[16 + h];
            const float f_b = ((h & 1) ? bfhi(gwd[(24 + h) >> 1]) : bflo(gwd[(24 + h) >> 1])) + gb[24 + h];
            float bf_ = logsigmoidf_(f_f), bb_ = logsigmoidf_(f_b);
#pragma unroll
            for (int d = 1; d < 64; d <<= 1) { const float tf = shup(bf_, d, F.lane), tb = shdn(bb_, d, F.lane); if (F.lane >= d) bf_ += tf; if (F.lane + d < 64) bb_ += tb; }
            const float af = i_f - bf_, ab_ = i_b - bb_;
            float pf = af, pb = ab_;
#pragma unroll
            for (int d = 1; d < 64; d <<= 1) { const float tf = shup(pf, d, F.lane), tb = shdn(pb, d, F.lane); if (F.lane >= d) pf = fmaxf(pf, tf); if (F.lane + d < 64) pb = fmaxf(pb, tb); }
            G[(size_t)row * 16 + h] = (f32x4){af, bf_, pf, 0.f};
            G[(size_t)row * 16 + 8 + h] = (f32x4){ab_, bb_, pb, 0.f};
        }
    }
}

__device__ __forceinline__ unsigned off_b(unsigned row, unsigned ch) { return 256u * row + 16u * (ch ^ (((row & 3u) << 2) | ((row >> 2) & 3u))); }
__device__ __forceinline__ unsigned tr_addr16(unsigned lane, unsigned c, unsigned ks, unsigned t) {
    const unsigned g = lane >> 4, q = (lane & 15u) >> 2, p = lane & 3u;
    return off_b(32u * ks + 8u * g + 4u * t + q, 2u * c + (p >> 1)) + 8u * (p & 1u);
}
typedef short s16x4 __attribute__((ext_vector_type(4)));
__device__ __forceinline__ s16x4 tr_read(unsigned addr) { s16x4 r; asm volatile("ds_read_b64_tr_b16 %0, %1" : "=&v"(r) : "v"(addr) : "memory"); return r; }
#define TR_WAIT2(a, b) asm volatile("s_waitcnt lgkmcnt(0)" : "+v"(a), "+v"(b) :: "memory")
__device__ __forceinline__ bf16x8 cat4(s16x4 lo, s16x4 hi) { return (bf16x8){lo[0], lo[1], lo[2], lo[3], hi[0], hi[1], hi[2], hi[3]}; }

__device__ __forceinline__ void phase_c2a(const Frame& F0, bool last_layer, int cl0, int cl1) {
    Frame F = refresh(F0);
    if (F.bid >= 64) { if (cl1 > cl0) moe_convert(F, cl0, cl1, (F.bid - 64) * 8 + F.wave, (F.G - 64) * 8); return; }
    const int b = F.bid >> 4, h = (F.bid >> 1) & 7, dir = F.bid & 1;
    constexpr int LD = 72, NCH = (CTXL + SEQ) / 64, LH = 136;
    constexpr int O_KS = 2 * 64 * LD * 2, O_KW = O_KS / 2 * 2 + 0, IN_BYTES = 2 * 64 * LD * 2 + 8192 + 16384 + 1024;
    constexpr int OFF_KW = 2 * 64 * LD * 2, OFF_V = OFF_KW + 8192, OFF_AB = OFF_V + 16384;
    LAS unsigned char* L0 = F.lds;
    LAS bf16_t* Sb = (LAS bf16_t*)(L0 + 2 * IN_BYTES); LAS bf16_t* Hs = Sb + 64 * LD;
    LAS float* MT = (LAS float*)(Hs + 64 * LH);
    LAS float* rdn_s = MT + 4 * NCH;
    constexpr int LDS_USED = 2 * IN_BYTES + 64 * LD * 2 + 64 * LH * 2 + 4 * NCH * 4 + 256;
    static_assert(LDS_USED <= MISC_OFF && (O_KS | O_KW) >= 0, "C2a LDS map");
    { LAS unsigned* z = (LAS unsigned*)L0; for (int i = F.tid; i < LDS_USED / 4; i += 512) z[i] = 0u; }
    const bf16_t* QK = (const bf16_t*)(WSP(F) + WS_AUX + AUX_QK);
    const bf16_t* P = (const bf16_t*)(WSP(F) + WS_P);
    const f32x4* G = (const f32x4*)(WSP(F) + WS_GATES);
    bf16_t* HD = (bf16_t*)(WSP(F) + WS_HDIR) + (size_t)dir * NTOK * DM;
    __syncthreads();
    if (F.tid < NCH) { const f32x4 g = G[(size_t)scan_row(b, dir, F.tid * 64 + 63) * 16 + dir * 8 + h]; MT[2 * NCH + F.tid] = g.y; MT[3 * NCH + F.tid] = g.z; }
    __syncthreads();
    if (F.tid == 0) { float m = 0.f;
        for (int c = 0; c < NCH; ++c) { const float cm63 = fmaxf(m, MT[3 * NCH + c]); MT[c] = m; MT[NCH + c] = cm63; m = MT[2 * NCH + c] + cm63; } }
    __syncthreads();
    const int fr = F.lane & 15, fq = F.lane >> 4;
    const int qr = F.tid >> 3, qc = F.tid & 7;
    u32x4 rq, rk, rv0, rv1; float ra = 0.f; f32x4 rab = (f32x4){0.f, 0.f, 0.f, 0.f};
#define C2A_LOAD(c) do { const int p0_ = (c) * 64; \
        const size_t rowq = (size_t)scan_row(b, dir, p0_ + qr); \
        rq = *(const u32x4*)(QK + rowq * DM + h * 64 + qc * 8); rk = *(const u32x4*)(QK + rowq * DM + 512 + h * 64 + qc * 8); \
        ra = ((const float*)(G + rowq * 16 + dir * 8 + h))[0]; \
        rv0 = *(const u32x4*)(P + (size_t)scan_row(b, dir, p0_ + (F.tid >> 4)) * NPAD_A + 1024 + h * 128 + (F.tid & 15) * 8); \
        rv1 = *(const u32x4*)(P + (size_t)scan_row(b, dir, p0_ + 32 + (F.tid >> 4)) * NPAD_A + 1024 + h * 128 + (F.tid & 15) * 8); \
        if (F.tid < 64) rab = G[(size_t)scan_row(b, dir, p0_ + F.tid) * 16 + dir * 8 + h]; } while (0)
#define C2A_STAGE(c, buf) do { LAS unsigned char* B_ = L0 + (buf) * IN_BYTES; \
        *(LAS u32x4*)(B_ + (qr * LD + qc * 8) * 2) = rq; *(LAS u32x4*)(B_ + 64 * LD * 2 + (qr * LD + qc * 8) * 2) = rk; \
        { const float wg_ = __expf(ra - MT[NCH + (c)]); u32x4 kw_; \
          kw_.x = cvt_pk_bf16(bflo(rk.x) * wg_, bfhi(rk.x) * wg_); kw_.y = cvt_pk_bf16(bflo(rk.y) * wg_, bfhi(rk.y) * wg_); kw_.z = cvt_pk_bf16(bflo(rk.z) * wg_, bfhi(rk.z) * wg_); kw_.w = cvt_pk_bf16(bflo(rk.w) * wg_, bfhi(rk.w) * wg_); \
          *(LAS u32x4*)(B_ + OFF_KW + off_b(qr & 31, 8 * (qr >> 5) + qc)) = kw_; } \
        *(LAS u32x4*)(B_ + OFF_V + off_b(F.tid >> 4, F.tid & 15)) = rv0; *(LAS u32x4*)(B_ + OFF_V + off_b(32 + (F.tid >> 4), F.tid & 15)) = rv1; \
        if (F.tid < 64) { const float mc_ = MT[(c)], cm_ = fmaxf(mc_, rab.z); \
            ((LAS f32x4*)(B_ + OFF_AB))[F.tid] = (f32x4){rab.x, cm_, __expf(mc_ - cm_), __expf(-(rab.y + cm_))}; } } while (0)
    C2A_LOAD(0); C2A_STAGE(0, 0); C2A_LOAD(1);
    f32x4 CT[4], CN[4];
#pragma unroll
    for (int i = 0; i < 4; ++i) { CT[i] = (f32x4){0.f, 0.f, 0.f, 0.f}; CN[i] = (f32x4){0.f, 0.f, 0.f, 0.f}; }
    const bf16x8 ONES = (bf16x8){0x3F80, 0x3F80, 0x3F80, 0x3F80, 0x3F80, 0x3F80, 0x3F80, 0x3F80};
    const unsigned lbase = (unsigned)(size_t)L0;
    for (int c = 0; c <= NCH; ++c) {
        __syncthreads();
        const int buf = c & 1;
        if (c + 1 < NCH) C2A_STAGE(c + 1, buf ^ 1);
        if (c > 0 && !(last_layer && c - 1 < CTXL / 64)) {
            const int row0 = scan_row(b, dir, (c - 1) * 64), rstep = dir ? -1 : 1;
#pragma unroll
            for (int i = 0; i < 2; ++i) { const int pc = F.tid + 512 * i, r_ = pc >> 4, ch_ = pc & 15;
                const u32x4 nw = *(const LAS u32x4*)(Hs + r_ * LH + ch_ * 8); const float rd_ = rdn_s[r_];
                u32x4 hw; hw.x = cvt_pk_bf16(bflo(nw.x) * rd_, bfhi(nw.x) * rd_); hw.y = cvt_pk_bf16(bflo(nw.y) * rd_, bfhi(nw.y) * rd_); hw.z = cvt_pk_bf16(bflo(nw.z) * rd_, bfhi(nw.z) * rd_); hw.w = cvt_pk_bf16(bflo(nw.w) * rd_, bfhi(nw.w) * rd_);
                *(u32x4*)(HD + (size_t)(row0 + rstep * r_) * DM + h * 128 + ch_ * 8) = hw; }
        }
        if (c == NCH) break;
        if (c + 2 < NCH) C2A_LOAD(c + 2);
        const LAS bf16_t* Qs = (const LAS bf16_t*)(L0 + buf * IN_BYTES); const LAS bf16_t* Ks = Qs + 64 * LD;
        const LAS f32x4* AB = (const LAS f32x4*)(L0 + buf * IN_BYTES + OFF_AB);
        const float mc = MT[c];
        for (int id = F.wave; id < 10; id += 8) {
            int ti, si; tri_tile(id, ti, si);
            f32x4 acc = (f32x4){0.f, 0.f, 0.f, 0.f};
#pragma unroll
            for (int kk = 0; kk < 2; ++kk) acc = MMA16(lds_frag(Qs, LD, ti * 16, kk * 32, fr, fq), lds_frag(Ks, LD, si * 16, kk * 32, fr, fq), acc);
            const int s_ = si * 16 + fr; const float as = AB[s_].x;
#pragma unroll
            for (int j = 0; j < 4; ++j) { const int t = ti * 16 + fq * 4 + j; const float w = (s_ <= t) ? __expf(as - AB[t].y) : 0.f; Sb[t * LD + s_] = f2bf(acc[j] * w); }
        }
        __syncthreads();
        const float decay = __expf(mc - MT[NCH + c]);
        const unsigned vbase = lbase + buf * IN_BYTES + OFF_V, kbase = lbase + buf * IN_BYTES + OFF_KW;
        s16x4 v00 = tr_read(vbase + tr_addr16(F.lane, F.wave, 0, 0)), v01 = tr_read(vbase + tr_addr16(F.lane, F.wave, 0, 1));
        s16x4 v10 = tr_read(vbase + tr_addr16(F.lane, F.wave, 1, 0)), v11 = tr_read(vbase + tr_addr16(F.lane, F.wave, 1, 1));
        TR_WAIT2(v00, v01); TR_WAIT2(v10, v11);
        const bf16x8 vf0 = cat4(v00, v01), vf1 = cat4(v10, v11);
        const bool denw = F.wave < 4;
        bf16x8 cb[2], nb[2];
#pragma unroll
        for (int kk = 0; kk < 2; ++kk) {
            u32x4 w; w.x = cvt_pk_bf16(CT[2 * kk][0], CT[2 * kk][1]); w.y = cvt_pk_bf16(CT[2 * kk][2], CT[2 * kk][3]); w.z = cvt_pk_bf16(CT[2 * kk + 1][0], CT[2 * kk + 1][1]); w.w = cvt_pk_bf16(CT[2 * kk + 1][2], CT[2 * kk + 1][3]);
            cb[kk] = __builtin_bit_cast(bf16x8, w);
            u32x4 x; x.x = cvt_pk_bf16(CN[2 * kk][0], CN[2 * kk][1]); x.y = cvt_pk_bf16(CN[2 * kk][2], CN[2 * kk][3]); x.z = cvt_pk_bf16(CN[2 * kk + 1][0], CN[2 * kk + 1][1]); x.w = cvt_pk_bf16(CN[2 * kk + 1][2], CN[2 * kk + 1][3]);
            nb[kk] = __builtin_bit_cast(bf16x8, x); }
#pragma unroll
        for (int ti = 0; ti < 4; ++ti) {
            f32x4 aC = (f32x4){0.f, 0.f, 0.f, 0.f}, aS = aC;
            bf16x8 qa[2];
#pragma unroll
            for (int kk = 0; kk < 2; ++kk) {
                const u32x2 qlo = *(const LAS u32x2*)(Qs + (ti * 16 + fr) * LD + kk * 32 + 4 * fq), qhi = *(const LAS u32x2*)(Qs + (ti * 16 + fr) * LD + kk * 32 + 16 + 4 * fq);
                const u32x4 qw = (u32x4){qlo.x, qlo.y, qhi.x, qhi.y}; qa[kk] = __builtin_bit_cast(bf16x8, qw);
                aC = MMA16(qa[kk], cb[kk], aC); }
            const bf16x8 sa0 = lds_frag(Sb, LD, ti * 16, 0, fr, fq); aS = MMA16(sa0, vf0, aS);
            bf16x8 sa1 = sa0; if (ti >= 2) { sa1 = lds_frag(Sb, LD, ti * 16, 32, fr, fq); aS = MMA16(sa1, vf1, aS); }
            f32x4 gg[4];
#pragma unroll
            for (int j = 0; j < 4; ++j) gg[j] = AB[ti * 16 + fq * 4 + j];
#pragma unroll
            for (int j = 0; j < 4; ++j) Hs[(ti * 16 + fq * 4 + j) * LH + F.wave * 16 + fr] = f2bf(gg[j].z * aC[j] + aS[j]);
            if (denw && F.wave == ti) {
                f32x4 aCn = (f32x4){0.f, 0.f, 0.f, 0.f}, aSn = aCn;
                aCn = MMA16(qa[0], nb[0], aCn); aCn = MMA16(qa[1], nb[1], aCn);
                aSn = MMA16(sa0, ONES, aSn); if (ti >= 2) aSn = MMA16(sa1, ONES, aSn);
                if (fr == 0) {
#pragma unroll
                    for (int j = 0; j < 4; ++j) rdn_s[ti * 16 + fq * 4 + j] = __builtin_amdgcn_rcpf(fmaxf(fabsf(gg[j].z * aCn[j] + aSn[j]), gg[j].w)); }
            }
        }
        s16x4 kq[4][4];
#pragma unroll
        for (int di = 0; di < 4; ++di) { kq[di][0] = tr_read(kbase + tr_addr16(F.lane, di, 0, 0)); kq[di][1] = tr_read(kbase + tr_addr16(F.lane, di, 0, 1));
            kq[di][2] = tr_read(kbase + tr_addr16(F.lane, 4 + di, 0, 0)); kq[di][3] = tr_read(kbase + tr_addr16(F.lane, 4 + di, 0, 1)); }
#pragma unroll
        for (int di = 0; di < 4; ++di) { TR_WAIT2(kq[di][0], kq[di][1]); TR_WAIT2(kq[di][2], kq[di][3]); }
#pragma unroll
        for (int di = 0; di < 4; ++di) {
            const bf16x8 kf0 = cat4(kq[di][0], kq[di][1]), kf1 = cat4(kq[di][2], kq[di][3]);
            f32x4 a = CT[di] * decay;
            a = MMA16(kf0, vf0, a); a = MMA16(kf1, vf1, a); CT[di] = a;
            if (denw) { f32x4 an = CN[di] * decay; an = MMA16(kf0, ONES, an); an = MMA16(kf1, ONES, an); CN[di] = an; }
        }
    }
#undef C2A_LOAD
#undef C2A_STAGE
}

__device__ __forceinline__ void phase_c3a(const Frame& F0, int jl) {
    Frame F = refresh(F0);
    const int gw = F.bid * 8 + F.wave, NGW = F.G * 8;
    const bf16_t* P = (const bf16_t*)(WSP(F) + WS_P);
    const bf16_t* H0 = (const bf16_t*)(WSP(F) + WS_HDIR); const bf16_t* H1 = H0 + (size_t)NTOK * DM;
    bf16_t* Y = (bf16_t*)(WSP(F) + WS_YPRE);
    const float* ng = INP(F, I_MNG) + (size_t)jl * DM;
    f32x4 g[4];
#pragma unroll
    for (int j = 0; j < 4; ++j) g[j] = *((const f32x4*)ng + F.lane + 64 * j);
    constexpr int NR = 4;
    for (int row0 = gw; row0 < NTOK; row0 += NR * NGW) {
        int row[NR]; bool ok[NR]; u32x2 a[NR][4], bq[NR][4], ov[NR][4];
#pragma unroll
        for (int q = 0; q < NR; ++q) { row[q] = row0 + q * NGW; ok[q] = row[q] < NTOK; if (!ok[q]) row[q] = row0;
#pragma unroll
            for (int j = 0; j < 4; ++j) {
                a[q][j] = *((const u32x2*)(H0 + (size_t)row[q] * DM) + F.lane + 64 * j); bq[q][j] = *((const u32x2*)(H1 + (size_t)row[q] * DM) + F.lane + 64 * j);
                ov[q][j] = *((const u32x2*)(P + (size_t)row[q] * NPAD_A + 2048) + F.lane + 64 * j); } }
        f32x4 x[NR][4]; float ss[NR][4];
#pragma unroll
        for (int q = 0; q < NR; ++q)
#pragma unroll
            for (int j = 0; j < 4; ++j) { x[q][j] = (f32x4){bflo(a[q][j].x) + bflo(bq[q][j].x), bfhi(a[q][j].x) + bfhi(bq[q][j].x), bflo(a[q][j].y) + bflo(bq[q][j].y), bfhi(a[q][j].y) + bfhi(bq[q][j].y)};
                ss[q][j] = (x[q][j].x * x[q][j].x + x[q][j].y * x[q][j].y) + (x[q][j].z * x[q][j].z + x[q][j].w * x[q][j].w); }
#pragma unroll
        for (int q = 0; q < NR; ++q)
#pragma unroll
            for (int j = 0; j < 4; ++j) ss[q][j] = half_sum(ss[q][j]);
#pragma unroll
        for (int q = 0; q < NR; ++q) {
            if (!ok[q]) continue;
#pragma unroll
            for (int j = 0; j < 4; ++j) {
                const float rstd = rsqrtf(ss[q][j] * (1.f / 128.f) + NORM_EPS);
                const f32x4 o4 = (f32x4){bflo(ov[q][j].x), bfhi(ov[q][j].x), bflo(ov[q][j].y), bfhi(ov[q][j].y)};
                f32x4 y = x[q][j] * rstd * g[j];
                y.x *= sigmoidf_(o4.x); y.y *= sigmoidf_(o4.y); y.z *= sigmoidf_(o4.z); y.w *= sigmoidf_(o4.w);
                u32x2 w; w.x = cvt_pk_bf16(y.x, y.y); w.y = cvt_pk_bf16(y.z, y.w);
                *((u32x2*)(Y + (size_t)row[q] * DM) + F.lane + 64 * j) = w; }
        }
    }
}

constexpr int KVLEN = CTXL + SEQ;
__device__ __forceinline__ void phase_c1b(const Frame& F0) {
    Frame F = refresh(F0);
    const int gw = F.bid * 8 + F.wave, NGW = F.G * 8;
    const bf16_t* P = (const bf16_t*)(WSP(F) + WS_P);
    bf16_t* Qb = (bf16_t*)(WSP(F) + WS_AUX + AUX_QK); bf16_t* Kb = (bf16_t*)(WSP(F) + WS_AUX + AUX_KB); bf16_t* Vb = (bf16_t*)(WSP(F) + WS_AUX + AUX_VB);
    const int l32 = F.lane & 31;
    const f32x4 qg = *((const f32x4*)INP(F, I_AQG) + l32), kg = *((const f32x4*)INP(F, I_AKG) + l32);
    float inv[4];
#pragma unroll
    for (int i = 0; i < 4; ++i) { const int d = 4 * l32 + i; inv[i] = exp2f(-(float)(d & 31) * (13.287712379549449f / 32.f)); }
    const bool second = (l32 & 8) != 0;
    const bool colhalf = l32 >= 16;
    for (int row = gw; row < NTOK; row += NGW) {
        const bool isctx = row < NCTXR;
        const int b = isctx ? (row >> 8) : ((row - NCTXR) >> 12), t = isctx ? (row & 255) : ((row - NCTXR) & 4095);
        const int kvpos = isctx ? t : CTXL + t;
        float cs[4], sn[4];
        { const float pos = (float)(colhalf ? (t & 63) : (t >> 6));
#pragma unroll
          for (int i = 0; i < 4; ++i) { const float ang = pos * inv[i]; cs[i] = isctx ? 1.f : __cosf(ang); sn[i] = isctx ? 0.f : __sinf(ang); } }
        const bf16_t* pr = P + (size_t)row * NPAD_B;
#pragma unroll
        for (int j = 0; j < 6; ++j) {
            const u32x2 w = *((const u32x2*)pr + F.lane + 64 * j);
            f32x4 x = (f32x4){bflo(w.x), bfhi(w.x), bflo(w.y), bfhi(w.y)};
            float ss = (x.x * x.x + x.y * x.y) + (x.z * x.z + x.w * x.w);
            ss = half_sum(ss);
            const float rstd = rsqrtf(ss * (1.f / 128.f) + NORM_EPS);
            x = x * rstd * (j < 4 ? qg : kg);
            float xv[4] = {x.x, x.y, x.z, x.w}, ov[4];
#pragma unroll
            for (int i = 0; i < 4; ++i) { const float pv = xch<8>(xv[i], F.lane);
                ov[i] = second ? (pv * sn[i] + xv[i] * cs[i]) : (xv[i] * cs[i] - pv * sn[i]); }
            u32x2 o; o.x = cvt_pk_bf16(ov[0], ov[1]); o.y = cvt_pk_bf16(ov[2], ov[3]);
            if (j < 4) *((u32x2*)(Qb + (size_t)row * DM) + F.lane + 64 * j) = o;
            else *((u32x2*)(Kb + ((size_t)b * KVLEN + kvpos) * 512) + F.lane + 64 * (j - 4)) = o;
        }
#pragma unroll
        for (int j = 0; j < 2; ++j) *((u32x2*)(Vb + ((size_t)b * KVLEN + kvpos) * 512) + F.lane + 64 * j) = *((const u32x2*)(pr + 1536) + F.lane + 64 * j);
    }
}

namespace att {
constexpr int D = 128, NW = 8, QBLK = 32, KVBLK = 64;
constexpr float SCALE = 0.088388347648318440f;
constexpr float THR = 8.f;
constexpr int LDQ = 1024, LDK = 512, LDO = 1024;
constexpr size_t SHM_V = KVBLK * D * 2, SHM_K = KVBLK * D * 2, SHM_ATTN = 2 * SHM_V + 2 * SHM_K + NW * 64 * 4;
using s16x4 = __attribute__((ext_vector_type(4))) short;
using f32x16 = __attribute__((ext_vector_type(16))) float;
#define KSWZ(row, colB) ((row) * 256 + ((colB) ^ (((row) & 7) << 4)))
#define SBAR() __builtin_amdgcn_sched_barrier(0)
__device__ __forceinline__ int crow(int r, int hi) { return (r & 3) + 8 * (r >> 2) + 4 * hi; }
__device__ __forceinline__ unsigned cvtpk(float lo, float hi) { unsigned r; asm volatile("v_cvt_pk_bf16_f32 %0, %1, %2" : "=v"(r) : "v"(lo), "v"(hi)); return r; }
__device__ __forceinline__ void partialSM(f32x16& p0, f32x16& p1, float& m_reg, float& mn, float& alpha) {
  constexpr float C = SCALE * 1.4426950408889634f;
  float pmax = p0[0]; for (int r = 1; r < 16; ++r) pmax = fmaxf(pmax, p0[r]); for (int r = 0; r < 16; ++r) pmax = fmaxf(pmax, p1[r]);
  { auto rr = __builtin_amdgcn_permlane32_swap(__float_as_uint(pmax), __float_as_uint(pmax), false, false);
    pmax = fmaxf(__uint_as_float(rr[0]), __uint_as_float(rr[1])); }
  if (__builtin_expect(__all(pmax - m_reg <= THR / SCALE), 1)) { mn = m_reg; alpha = 1.f; }
  else { mn = fmaxf(m_reg, pmax); alpha = __builtin_amdgcn_exp2f((m_reg - mn) * C); m_reg = mn; }
  float mnC = -mn * C;
  for (int r = 0; r < 16; ++r) p0[r] = fmaf(p0[r], C, mnC); for (int r = 0; r < 16; ++r) p1[r] = fmaf(p1[r], C, mnC);
  for (int r = 0; r < 16; ++r) p0[r] = __builtin_amdgcn_exp2f(p0[r]);
}
__device__ __forceinline__ void finishSM(f32x16& p0, f32x16& p1, float alpha, float& l_reg, bf16x8& pa0, bf16x8& pa1, bf16x8& pa2, bf16x8& pa3) {
  for (int r = 0; r < 16; ++r) p1[r] = __builtin_amdgcn_exp2f(p1[r]);
  float ps = 0; for (int r = 0; r < 16; ++r) ps += p0[r]; for (int r = 0; r < 16; ++r) ps += p1[r];
  { auto rr = __builtin_amdgcn_permlane32_swap(__float_as_uint(ps), __float_as_uint(ps), false, false);
    ps = __uint_as_float(rr[0]) + __uint_as_float(rr[1]); }
  l_reg = l_reg * alpha + ps;
#define PK4(P, BASE, OUT) do { unsigned a0 = cvtpk(P[BASE + 0], P[BASE + 1]), a1 = cvtpk(P[BASE + 2], P[BASE + 3]);   \
    unsigned b0 = cvtpk(P[BASE + 4], P[BASE + 5]), b1 = cvtpk(P[BASE + 6], P[BASE + 7]);                              \
    auto r0 = __builtin_amdgcn_permlane32_swap(a0, b0, false, false); auto r1 = __builtin_amdgcn_permlane32_swap(a1, b1, false, false); \
    u32x4 w = {r0[0], r1[0], r0[1], r1[1]}; OUT = *reinterpret_cast<bf16x8*>(&w); } while (0)
  PK4(p0, 0, pa0); PK4(p0, 8, pa1); PK4(p1, 0, pa2); PK4(p1, 8, pa3);
#undef PK4
}
__device__ __forceinline__ void qkt(f32x16& p0, f32x16& p1, const bf16_t* Ks, const bf16x8* qr, int r32, int hi) {
  p0 = f32x16{}; p1 = f32x16{};
  for (int d0 = 0; d0 < 8; ++d0) { int cb = (d0 * 16 + hi * 8) * 2;
    bf16x8 b0 = *reinterpret_cast<const bf16x8*>((const char*)Ks + KSWZ(r32, cb));
    bf16x8 b1 = *reinterpret_cast<const bf16x8*>((const char*)Ks + KSWZ(32 + r32, cb));
    p0 = __builtin_amdgcn_mfma_f32_32x32x16_bf16(b0, qr[d0], p0, 0, 0, 0);
    p1 = __builtin_amdgcn_mfma_f32_32x32x16_bf16(b1, qr[d0], p1, 0, 0, 0); }
}
__device__ __forceinline__ int v_st(int k, int c) { const int kk = (k & ~0xC) | ((k & 4) << 1) | ((k & 8) >> 1); return ((kk >> 3) * 4 + (c >> 5)) * 512 + ((kk & 7) * 32 + (c & 31)) * 2; }
__device__ __forceinline__ int v_rd_base(int lane) { return ((lane & 3) << 3) | (((lane >> 2) & 3) << 6) | (((lane >> 4) & 1) << 5) | (((lane >> 5) & 1) << 8); }
constexpr int v_rd_off(int d0, int ks, int half) { return d0 * 512 + ks * 4096 + half * 2048; }
template <int OFF> __device__ __forceinline__ s16x4 tr_read(int vb) {
  s16x4 r; asm volatile("ds_read_b64_tr_b16 %0, %1 offset:%2" : "=&v"(r) : "v"(vb), "i"(OFF) : "memory"); return r;
}
template <int D0> __device__ __forceinline__ void pv_one(f32x16& od, int vb, bf16x8 pa0, bf16x8 pa1, bf16x8 pa2, bf16x8 pa3) {
  const s16x4 l0 = tr_read<v_rd_off(D0, 0, 0)>(vb), h0 = tr_read<v_rd_off(D0, 0, 1)>(vb), l1 = tr_read<v_rd_off(D0, 1, 0)>(vb), h1 = tr_read<v_rd_off(D0, 1, 1)>(vb);
  const s16x4 l2 = tr_read<v_rd_off(D0, 2, 0)>(vb), h2 = tr_read<v_rd_off(D0, 2, 1)>(vb), l3 = tr_read<v_rd_off(D0, 3, 0)>(vb), h3 = tr_read<v_rd_off(D0, 3, 1)>(vb);
  asm volatile("s_waitcnt lgkmcnt(0)" ::: "memory"); SBAR();
#define PK(L, H) (bf16x8){L[0], L[1], L[2], L[3], H[0], H[1], H[2], H[3]}
  od = __builtin_amdgcn_mfma_f32_32x32x16_bf16(pa0, PK(l0, h0), od, 0, 0, 0);
  od = __builtin_amdgcn_mfma_f32_32x32x16_bf16(pa1, PK(l1, h1), od, 0, 0, 0);
  od = __builtin_amdgcn_mfma_f32_32x32x16_bf16(pa2, PK(l2, h2), od, 0, 0, 0);
  od = __builtin_amdgcn_mfma_f32_32x32x16_bf16(pa3, PK(l3, h3), od, 0, 0, 0);
#undef PK
}
__device__ __forceinline__ void pv_d0(f32x16* o, int vb, bf16x8 pa0, bf16x8 pa1, bf16x8 pa2, bf16x8 pa3) {
  pv_one<0>(o[0], vb, pa0, pa1, pa2, pa3); pv_one<1>(o[1], vb, pa0, pa1, pa2, pa3); pv_one<2>(o[2], vb, pa0, pa1, pa2, pa3); pv_one<3>(o[3], vb, pa0, pa1, pa2, pa3);
}
__device__ __forceinline__ void attn_dense_body(const bf16_t* __restrict__ Qb, const bf16_t* __restrict__ Kh, const bf16_t* __restrict__ Vh,
                                                bf16_t* __restrict__ Ob, int seq, char* lds) {
  int tz_ = threadIdx.x; asm volatile("" : "+v"(tz_));
  const int tid = tz_, wid = tid >> 6, lane = tid & 63, r32 = lane & 31, hi = lane >> 5;
  bf16_t* V_lds = (bf16_t*)lds; bf16_t* K_lds = (bf16_t*)(lds + 2 * SHM_V);
  float* ws = (float*)(lds + 2 * SHM_V + 2 * SHM_K) + wid * 64; float* li_l = ws; float* al_l = ws + 32;
  float m_reg = -1e30f, l_reg = 0; f32x16 o[4] = {}; bf16x8 qr[8];
  const bf16_t* Qw = Qb + (long)(wid * QBLK + r32) * LDQ + hi * 8;
#pragma unroll
  for (int d0 = 0; d0 < 8; ++d0) qr[d0] = *reinterpret_cast<const bf16x8*>(Qw + d0 * 16);
  const int sr = tid >> 4, sc = (tid & 15) * 8, vst0 = v_st(sr, sc), vst1 = v_st(32 + sr, sc);
  const int vb0 = (int)(uintptr_t)V_lds + v_rd_base(lane);
  struct { bf16x8 vs0, vs1, ks0, ks1; } sr_[2];
#define SLOAD(i, k0) do { sr_[i].vs0 = *reinterpret_cast<const bf16x8*>(&Vh[(long)((k0) + sr) * LDK + sc]); sr_[i].vs1 = *reinterpret_cast<const bf16x8*>(&Vh[(long)((k0) + 32 + sr) * LDK + sc]); \
    sr_[i].ks0 = *reinterpret_cast<const bf16x8*>(&Kh[(long)((k0) + sr) * LDK + sc]); sr_[i].ks1 = *reinterpret_cast<const bf16x8*>(&Kh[(long)((k0) + 32 + sr) * LDK + sc]); } while (0)
#define SWRITE(b, i) do { *(bf16x8*)((char*)V_lds + (b) * SHM_V + vst0) = sr_[i].vs0;          \
    *(bf16x8*)((char*)V_lds + (b) * SHM_V + vst1) = sr_[i].vs1; int kc = sc * 2;               \
    *(bf16x8*)((char*)K_lds + (b) * SHM_K + KSWZ(sr, kc)) = sr_[i].ks0;                       \
    *(bf16x8*)((char*)K_lds + (b) * SHM_K + KSWZ(32 + sr, kc)) = sr_[i].ks1; } while (0)
#define SWAIT() asm volatile("s_waitcnt vmcnt(4)" ::: "memory")
#define RESC(a) do { if (__any((a) < 1.f)) { if (hi == 0) al_l[r32] = (a); asm volatile("s_waitcnt lgkmcnt(0)" ::: "memory"); \
    for (int d = 0; d < 4; ++d) for (int r = 0; r < 16; ++r) o[d][r] *= al_l[crow(r, hi)]; } } while (0)
  f32x16 pA0, pA1, pB0, pB1; float mnA, mnB, alA, alB; bf16x8 pa0, pa1, pa2, pa3; const int NT = seq / KVBLK;
  constexpr int SE = 0, SO = 1;
  SLOAD(SE, 0); asm volatile("s_waitcnt vmcnt(0)" ::: "memory"); SWRITE(0, SE); __syncthreads();
  qkt(pA0, pA1, K_lds, qr, r32, hi); partialSM(pA0, pA1, m_reg, mnA, alA);
  SLOAD(SO, KVBLK); if (2 < NT) SLOAD(SE, 2 * KVBLK);
  SWAIT(); SWRITE(1, SO); __syncthreads();
  for (int j = 1; j + 1 < NT; j += 2) {
    SBAR(); qkt(pB0, pB1, (bf16_t*)((char*)K_lds + SHM_K), qr, r32, hi);
    finishSM(pA0, pA1, alA, l_reg, pa0, pa1, pa2, pa3); SBAR();
    SLOAD(SO, (j + 2) * KVBLK); SBAR();
    pv_d0(o, vb0, pa0, pa1, pa2, pa3); partialSM(pB0, pB1, m_reg, mnB, alB);
    __syncthreads(); SWAIT(); SWRITE(0, SE);
    RESC(alB); __syncthreads();
    SBAR(); qkt(pA0, pA1, K_lds, qr, r32, hi);
    finishSM(pB0, pB1, alB, l_reg, pa0, pa1, pa2, pa3); SBAR();
    if (j + 3 < NT) SLOAD(SE, (j + 3) * KVBLK); SBAR();
    pv_d0(o, vb0 + (int)SHM_V, pa0, pa1, pa2, pa3); partialSM(pA0, pA1, m_reg, mnA, alA);
    __syncthreads(); SWAIT(); SWRITE(1, SO);
    RESC(alA); __syncthreads();
  }
  SBAR(); qkt(pB0, pB1, (bf16_t*)((char*)K_lds + SHM_K), qr, r32, hi);
  finishSM(pA0, pA1, alA, l_reg, pa0, pa1, pa2, pa3); SBAR();
  pv_d0(o, vb0, pa0, pa1, pa2, pa3); partialSM(pB0, pB1, m_reg, mnB, alB);
  __syncthreads(); RESC(alB);
  finishSM(pB0, pB1, alB, l_reg, pa0, pa1, pa2, pa3); SBAR();
  pv_d0(o, vb0 + (int)SHM_V, pa0, pa1, pa2, pa3);
  if (hi == 0) li_l[r32] = l_reg; asm volatile("s_waitcnt lgkmcnt(0)" ::: "memory");
  float rli[16];
#pragma unroll
  for (int r = 0; r < 16; ++r) rli[r] = __builtin_amdgcn_rcpf(li_l[crow(r, hi)]);
  bf16_t* Ow = Ob + (long)(wid * QBLK) * LDO;
#pragma unroll
  for (int r = 0; r < 16; ++r) { int orow = crow(r, hi);
    for (int d0 = 0; d0 < 4; ++d0) Ow[(long)orow * LDO + d0 * 32 + r32] = f2bf(o[d0][r] * rli[r]); }
#undef SLOAD
#undef SWRITE
#undef SWAIT
#undef RESC
}
#undef KSWZ
#undef SBAR
}

__device__ __forceinline__ void phase_c2b(const Frame& F0) {
    Frame F = refresh(F0);
    const bf16_t* Qb = (const bf16_t*)(WSP(F) + WS_AUX + AUX_QK); const bf16_t* Kb = (const bf16_t*)(WSP(F) + WS_AUX + AUX_KB); const bf16_t* Vb = (const bf16_t*)(WSP(F) + WS_AUX + AUX_VB);
    bf16_t* Y = (bf16_t*)(WSP(F) + WS_YPRE);
    for (int i = 0; i < 3; ++i) {
        int b, h, seq; size_t qrow;
        if (i < 2) { const int x = F.bid & 7, j = F.bid >> 3, g = 8 * i + x; b = g >> 2; h = (g & 3) * 2 + (j >> 4); qrow = (size_t)NCTXR + (size_t)b * SEQ + (size_t)(j & 15) * 256; seq = KVLEN; }
        else { if (F.bid >= 32) break; b = F.bid >> 3; h = F.bid & 7; qrow = (size_t)b * CTXL; seq = CTXL; }
        const size_t kvoff = (size_t)b * KVLEN * 512 + (size_t)(h >> 1) * 128;
        att::attn_dense_body(Qb + qrow * DM + h * 128, Kb + kvoff, Vb + kvoff, Y + qrow * DM + h * 128, seq, (char*)(unsigned char*)F.lds);
        __syncthreads();
    }
}

__device__ __forceinline__ void phase_c1c(const Frame& F0) {
    Frame F = refresh(F0);
    const bf16_t* P = (const bf16_t*)(WSP(F) + WS_P);
    LAS float* alow = (LAS float*)F.lds;
    const int c = F.tid;
    for (int it = F.bid; it < (NTOK / 64) * 2; it += F.G) {
        const int tc = it >> 1, dir = it & 1, row0 = tc * 64;
        bf16_t* QT = (bf16_t*)(WSP(F) + WS_AUX + AUX_QT) + (size_t)dir * NTOK * 512;
        bf16_t* KH = (bf16_t*)(WSP(F) + WS_AUX + AUX_KHT) + (size_t)dir * NTOK * 512;
        float* DEC = (float*)(WSP(F) + WS_AUX + AUX_DEC) + (size_t)(dir * (NTOK / 64) + tc) * 512;
        __syncthreads();
        for (int i = F.tid; i < 1024; i += 512) { const int t = i >> 4, r = i & 15; alow[i] = bf2f(P[(size_t)(row0 + t) * NPAD_A + 3072 + dir * 16 + r]); }
        float w2[16];
#pragma unroll
        for (int r = 0; r < 16; ++r) w2[r] = INP(F, I_GAW2)[(size_t)(dir * 16 + r) * 512 + c];
        const float ab = INP(F, I_GAB)[dir * 512 + c];
        __syncthreads();
        float tot = 0.f, lav[64];
#pragma unroll
        for (int t = 0; t < 64; ++t) { float s_ = ab;
#pragma unroll
            for (int r = 0; r < 16; ++r) s_ += alow[t * 16 + r] * w2[r];
            lav[t] = logsigmoidf_(s_) * (1.f / 16.f); tot += lav[t]; }
        float pex = 0.f;
        bf16_t qn[16], kn[16];
#pragma unroll
        for (int i = 0; i < 16; ++i) { qn[i] = P[(size_t)(row0 + i) * NPAD_A + c]; kn[i] = P[(size_t)(row0 + i) * NPAD_A + 512 + c]; }
#pragma unroll
        for (int g = 0; g < 4; ++g) {
            bf16_t qc[16], kc[16];
#pragma unroll
            for (int i = 0; i < 16; ++i) { qc[i] = qn[i]; kc[i] = kn[i]; }
            if (g < 3) {
#pragma unroll
                for (int i = 0; i < 16; ++i) { qn[i] = P[(size_t)(row0 + 16 * (g + 1) + i) * NPAD_A + c]; kn[i] = P[(size_t)(row0 + 16 * (g + 1) + i) * NPAD_A + 512 + c]; } }
#pragma unroll
            for (int i = 0; i < 16; ++i) {
                const int t = 16 * g + i;
                const float la = lav[t];
                const float bb = dir ? (tot - pex) : (pex + la);
                pex += la;
                const size_t row = (size_t)(row0 + t);
                const float q = bf2f(qc[i]) * 0.08838834764831845f, k = bf2f(kc[i]);
                QT[row * 512 + c] = f2bf(q * __expf(bb - tot)); KH[row * 512 + c] = f2bf(k * __expf(tot - bb));
            }
        }
        DEC[c] = __expf(tot);
    }
}

__device__ __forceinline__ void phase_c2c(const Frame& F0, bool last_layer, int cl0, int cl1) {
    Frame F = refresh(F0);
    if (F.bid >= 64) { if (cl1 > cl0) moe_convert(F, cl0, cl1, (F.bid - 64) * 8 + F.wave, (F.G - 64) * 8); return; }
    const int b = F.bid >> 4, h = (F.bid >> 2) & 3, dir = (F.bid >> 1) & 1, vh = F.bid & 1;
    constexpr int LQ = 136, LD = 72, LH = 136, NCH = (CTXL + SEQ) / 64;
    constexpr int OFF_KH = 64 * LQ * 2, OFF_V = OFF_KH + 16384, OFF_DEC = OFF_V + 16384, IN_BYTES = OFF_DEC + 512;
    constexpr int OFF_SB = 2 * IN_BYTES, OFF_HS = OFF_SB + 64 * LD * 2, LDS_USED = OFF_HS + 64 * LH * 2;
    static_assert(LDS_USED <= MISC_OFF, "C2c LDS map");
    LAS unsigned char* L0 = F.lds;
    LAS bf16_t* Sb = (LAS bf16_t*)(L0 + OFF_SB); LAS bf16_t* Hs = (LAS bf16_t*)(L0 + OFF_HS);
    { LAS unsigned* z = (LAS unsigned*)L0; for (int i = F.tid; i < LDS_USED / 4; i += 512) z[i] = 0u; }
    const bf16_t* QT = (const bf16_t*)(WSP(F) + WS_AUX + AUX_QT) + (size_t)dir * NTOK * 512;
    const bf16_t* KH = (const bf16_t*)(WSP(F) + WS_AUX + AUX_KHT) + (size_t)dir * NTOK * 512;
    const float* DEC = (const float*)(WSP(F) + WS_AUX + AUX_DEC) + (size_t)dir * (NTOK / 64) * 512;
    const bf16_t* P = (const bf16_t*)(WSP(F) + WS_P);
    bf16_t* HD = (bf16_t*)(WSP(F) + WS_HDIR) + (size_t)dir * NTOK * DM;
    const int fr = F.lane & 15, fq = F.lane >> 4;
    u32x4 rq[2], rh[2], rv[2]; float rd = 0.f;
#define C2C_LOAD(c) do { const int c_ = (c); const int p0_ = c_ * 64; \
        const int tc_ = (c_ < 4) ? (b * 4 + (dir ? 3 - c_ : c_)) : (16 + b * 64 + (dir ? 63 - (c_ - 4) : (c_ - 4))); \
        _Pragma("unroll") for (int i = 0; i < 2; ++i) { const int pc = F.tid + 512 * i, r_ = pc >> 4, ch_ = pc & 15; const size_t row_ = (size_t)scan_row(b, dir, p0_ + r_); \
            rq[i] = *(const u32x4*)(QT + row_ * 512 + h * 128 + ch_ * 8); rh[i] = *(const u32x4*)(KH + row_ * 512 + h * 128 + ch_ * 8); \
            rv[i] = *(const u32x4*)(P + row_ * NPAD_A + 1024 + h * 256 + vh * 128 + ch_ * 8); } \
        if (F.tid < 128) rd = DEC[(size_t)tc_ * 512 + h * 128 + F.tid]; } while (0)
#define C2C_STAGE(buf) do { LAS unsigned char* B_ = L0 + (buf) * IN_BYTES; \
        _Pragma("unroll") for (int i = 0; i < 2; ++i) { const int pc = F.tid + 512 * i, r_ = pc >> 4, ch_ = pc & 15; \
            *(LAS u32x4*)(B_ + (r_ * LQ + ch_ * 8) * 2) = rq[i]; *(LAS u32x4*)(B_ + OFF_KH + off_b(r_, ch_)) = rh[i]; *(LAS u32x4*)(B_ + OFF_V + off_b(r_, ch_)) = rv[i]; } \
        if (F.tid < 128) ((LAS float*)(B_ + OFF_DEC))[F.tid] = rd; } while (0)
    __syncthreads();
    C2C_LOAD(0); C2C_STAGE(0); C2C_LOAD(1);
    f32x4 ST[8];
#pragma unroll
    for (int i = 0; i < 8; ++i) ST[i] = (f32x4){0.f, 0.f, 0.f, 0.f};
    const unsigned lbase = (unsigned)(size_t)L0;
    for (int c = 0; c <= NCH; ++c) {
        __syncthreads();
        const int buf = c & 1;
        if (c + 1 < NCH) C2C_STAGE(buf ^ 1);
        if (c > 0 && !(last_layer && c - 1 < CTXL / 64)) {
            const int row0 = scan_row(b, dir, (c - 1) * 64), rstep = dir ? -1 : 1;
#pragma unroll
            for (int i = 0; i < 2; ++i) { const int pc = F.tid + 512 * i, r_ = pc >> 4, ch_ = pc & 15;
                *(u32x4*)(HD + (size_t)(row0 + rstep * r_) * DM + h * 256 + vh * 128 + ch_ * 8) = *(const LAS u32x4*)(Hs + r_ * LH + ch_ * 8); }
        }
        if (c == NCH) break;
        if (c + 2 < NCH) C2C_LOAD(c + 2);
        const LAS bf16_t* Qs = (const LAS bf16_t*)(L0 + buf * IN_BYTES);
        const LAS unsigned char* KHi = L0 + buf * IN_BYTES + OFF_KH;
        const LAS float* decs = (const LAS float*)(L0 + buf * IN_BYTES + OFF_DEC);
        for (int id = F.wave; id < 10; id += 8) {
            int ti, si; tri_tile(id, ti, si);
            f32x4 acc = (f32x4){0.f, 0.f, 0.f, 0.f};
#pragma unroll
            for (int kk = 0; kk < 4; ++kk) acc = MMA16(lds_frag(Qs, LQ, ti * 16, kk * 32, fr, fq), *(const LAS bf16x8*)(KHi + off_b(si * 16 + fr, 4 * kk + fq)), acc);
            const int s_ = si * 16 + fr;
#pragma unroll
            for (int j = 0; j < 4; ++j) { const int t = ti * 16 + fq * 4 + j; Sb[t * LD + s_] = f2bf((s_ <= t) ? acc[j] : 0.f); }
        }
        __syncthreads();
        const unsigned vbase = lbase + buf * IN_BYTES + OFF_V, kbase = lbase + buf * IN_BYTES + OFF_KH;
        s16x4 v00 = tr_read(vbase + tr_addr16(F.lane, F.wave, 0, 0)), v01 = tr_read(vbase + tr_addr16(F.lane, F.wave, 0, 1));
        s16x4 v10 = tr_read(vbase + tr_addr16(F.lane, F.wave, 1, 0)), v11 = tr_read(vbase + tr_addr16(F.lane, F.wave, 1, 1));
        TR_WAIT2(v00, v01); TR_WAIT2(v10, v11);
        const bf16x8 vf0 = cat4(v00, v01), vf1 = cat4(v10, v11);
#pragma unroll
        for (int di = 0; di < 8; ++di) ST[di] = ST[di] * *(const LAS f32x4*)(decs + di * 16 + fq * 4);
        bf16x8 sbf[4];
#pragma unroll
        for (int kk = 0; kk < 4; ++kk) {
            u32x4 w; w.x = cvt_pk_bf16(ST[2 * kk][0], ST[2 * kk][1]); w.y = cvt_pk_bf16(ST[2 * kk][2], ST[2 * kk][3]); w.z = cvt_pk_bf16(ST[2 * kk + 1][0], ST[2 * kk + 1][1]); w.w = cvt_pk_bf16(ST[2 * kk + 1][2], ST[2 * kk + 1][3]);
            sbf[kk] = __builtin_bit_cast(bf16x8, w); }
#pragma unroll
        for (int ti = 0; ti < 4; ++ti) {
            f32x4 a = (f32x4){0.f, 0.f, 0.f, 0.f};
#pragma unroll
            for (int kk = 0; kk < 4; ++kk) {
                const u32x2 qlo = *(const LAS u32x2*)(Qs + (ti * 16 + fr) * LQ + kk * 32 + 4 * fq), qhi = *(const LAS u32x2*)(Qs + (ti * 16 + fr) * LQ + kk * 32 + 16 + 4 * fq);
                const u32x4 qw = (u32x4){qlo.x, qlo.y, qhi.x, qhi.y};
                a = MMA16(__builtin_bit_cast(bf16x8, qw), sbf[kk], a); }
            a = MMA16(lds_frag(Sb, LD, ti * 16, 0, fr, fq), vf0, a);
            if (ti >= 2) a = MMA16(lds_frag(Sb, LD, ti * 16, 32, fr, fq), vf1, a);
#pragma unroll
            for (int j = 0; j < 4; ++j) Hs[(ti * 16 + fq * 4 + j) * LH + F.wave * 16 + fr] = f2bf(a[j]);
        }
#pragma unroll
        for (int dg = 0; dg < 2; ++dg) {
            s16x4 kq[4][4];
#pragma unroll
            for (int i = 0; i < 4; ++i) { const int di = dg * 4 + i; kq[i][0] = tr_read(kbase + tr_addr16(F.lane, di, 0, 0)); kq[i][1] = tr_read(kbase + tr_addr16(F.lane, di, 0, 1));
                kq[i][2] = tr_read(kbase + tr_addr16(F.lane, di, 1, 0)); kq[i][3] = tr_read(kbase + tr_addr16(F.lane, di, 1, 1)); }
#pragma unroll
            for (int i = 0; i < 4; ++i) { TR_WAIT2(kq[i][0], kq[i][1]); TR_WAIT2(kq[i][2], kq[i][3]); }
#pragma unroll
            for (int i = 0; i < 4; ++i) { const int di = dg * 4 + i; f32x4 a = ST[di];
                a = MMA16(cat4(kq[i][0], kq[i][1]), vf0, a); a = MMA16(cat4(kq[i][2], kq[i][3]), vf1, a); ST[di] = a; }
        }
    }
#undef C2C_LOAD
#undef C2C_STAGE
}

__device__ __forceinline__ void phase_c3c(const Frame& F0) {
    Frame F = refresh(F0);
    const int gw = F.bid * 8 + F.wave, NGW = F.G * 8;
    const bf16_t* P = (const bf16_t*)(WSP(F) + WS_P);
    const bf16_t* H0 = (const bf16_t*)(WSP(F) + WS_HDIR); const bf16_t* H1 = H0 + (size_t)NTOK * DM;
    bf16_t* Y = (bf16_t*)(WSP(F) + WS_YPRE);
    const float* ng = INP(F, I_GNG);
    f32x4 g[4];
#pragma unroll
    for (int j = 0; j < 4; ++j) g[j] = *((const f32x4*)ng + F.lane + 64 * j);
    constexpr int NR = 4;
    for (int row0 = gw; row0 < NTOK; row0 += NR * NGW) {
        int row[NR]; bool ok[NR]; u32x2 a[NR][4], bq[NR][4], gv[NR][4];
#pragma unroll
        for (int q = 0; q < NR; ++q) { row[q] = row0 + q * NGW; ok[q] = row[q] < NTOK; if (!ok[q]) row[q] = row0;
#pragma unroll
            for (int j = 0; j < 4; ++j) {
                a[q][j] = *((const u32x2*)(H0 + (size_t)row[q] * DM) + F.lane + 64 * j); bq[q][j] = *((const u32x2*)(H1 + (size_t)row[q] * DM) + F.lane + 64 * j);
                gv[q][j] = *((const u32x2*)(P + (size_t)row[q] * NPAD_A + 2048) + F.lane + 64 * j); } }
        f32x4 x[NR][4]; float ss[NR][4];
#pragma unroll
        for (int q = 0; q < NR; ++q)
#pragma unroll
            for (int j = 0; j < 4; ++j) { x[q][j] = (f32x4){bflo(a[q][j].x) + bflo(bq[q][j].x), bfhi(a[q][j].x) + bfhi(bq[q][j].x), bflo(a[q][j].y) + bflo(bq[q][j].y), bfhi(a[q][j].y) + bfhi(bq[q][j].y)};
                ss[q][j] = (x[q][j].x * x[q][j].x + x[q][j].y * x[q][j].y) + (x[q][j].z * x[q][j].z + x[q][j].w * x[q][j].w); }
#pragma unroll
        for (int q = 0; q < NR; ++q)
#pragma unroll
            for (int j = 0; j < 4; ++j) ss[q][j] = wave_sum(ss[q][j], F.lane);
#pragma unroll
        for (int q = 0; q < NR; ++q) {
            if (!ok[q]) continue;
#pragma unroll
            for (int j = 0; j < 4; ++j) {
                const float rstd = rsqrtf(ss[q][j] * (1.f / 256.f) + NORM_EPS);
                const f32x4 g4 = (f32x4){bflo(gv[q][j].x), bfhi(gv[q][j].x), bflo(gv[q][j].y), bfhi(gv[q][j].y)};
                f32x4 y = x[q][j] * rstd * g[j];
                y.x *= g4.x * sigmoidf_(g4.x); y.y *= g4.y * sigmoidf_(g4.y); y.z *= g4.z * sigmoidf_(g4.z); y.w *= g4.w * sigmoidf_(g4.w);
                u32x2 w; w.x = cvt_pk_bf16(y.x, y.y); w.y = cvt_pk_bf16(y.z, y.w);
                *((u32x2*)(Y + (size_t)row[q] * DM) + F.lane + 64 * j) = w; }
        }
    }
}

#ifndef PHSEL
#define PHSEL 0xFFFF
#endif
#define SEL(n) ((PHSEL >> (n)) & 1)
constexpr int N_PHASES = 42;
__global__ void __launch_bounds__(512, 2) mk_fwd(Args args) {
    extern __shared__ __attribute__((aligned(16))) unsigned char lds[];
    Frame F;
    F.lds = (LAS unsigned char*)lds;
    F.tid = threadIdx.x; F.lane = F.tid & 63; F.wave = __builtin_amdgcn_readfirstlane(F.tid >> 6);
    F.G = gridDim.x; F.bid = blockIdx.x;
    F.ka = (const CAS char*)__builtin_amdgcn_kernarg_segment_ptr();
    F.out_ = *(GAS float* const CAS*)(F.ka + 224); F.ws_ = *(GAS unsigned char* const CAS*)(F.ka + 232);
    volatile LAS unsigned* misc = (volatile LAS unsigned*)(F.lds + MISC_OFF);
    if (F.tid < 4) misc[F.tid] = 0u;
    __syncthreads();
    unsigned* ctl = (unsigned*)(WSP(F) + WS_CTL);
    XcdBarrier bar; bar.bar = ctl + CW_BAR; bar.x = 0; bar.st = misc;
    const int lo = args.ph_lo, hi = args.ph_hi;
    if (hi - lo > 1) bar = xcd_barrier_post(ctl + CW_BAR, misc);
#define IN(k) (lo <= (k) && (k) < hi)
#define END(k) do { if ((k) + 1 < hi) xcd_barrier(bar); } while (0)

    if (SEL(0) && IN(0)) { phase_p0(F); END(0); }
    for (int l = 0; l < DEPTH; ++l) {
        const int base = 1 + 10 * l, kind = l % 3, jl = l / 3;
        const int npad = (kind == 1) ? NPAD_B : NPAD_A;
        if (SEL(1) && IN(base + 0)) { phase_a(F, l); END(base + 0); }
        if (SEL(2) && IN(base + 1)) {
            g8::StaticSched S; S.init(WSP(F) + WS_U, WSP(F) + WS_WIN + (size_t)l * 7 * MiB, NTOK, npad, F.G, F.bid);
            g8::EpiBf16 E{(bf16_t*)(WSP(F) + WS_P), npad};
            g8::gemm_phase(F.lds, S, E);
            END(base + 1);
        }
        if (kind == 0) {
            if (SEL(3) && IN(base + 2)) { phase_c1a(F, jl); END(base + 2); }
            if (SEL(4) && IN(base + 3)) { phase_c2a(F, l == DEPTH - 1, l == 0 ? 0 : 3, l == 0 ? 2 : 4); END(base + 3); }
            if (SEL(5) && IN(base + 4)) { phase_c3a(F, jl); END(base + 4); }
        } else if (kind == 1) {
            if (SEL(6) && IN(base + 2)) { phase_c1b(F); END(base + 2); }
            if (SEL(7) && IN(base + 3)) { phase_c2b(F); END(base + 3); }
        } else {
            if (SEL(8) && IN(base + 2)) { phase_c1c(F); END(base + 2); }
            if (SEL(9) && IN(base + 3)) { phase_c2c(F, l == DEPTH - 1, 2, 3); END(base + 3); }
            if (SEL(10) && IN(base + 4)) { phase_c3c(F); END(base + 4); }
        }
        if (SEL(11) && IN(base + 5)) {
            const bool lastl = (l == DEPTH - 1);
            g8::StaticSched S; S.init(WSP(F) + WS_YPRE, WSP(F) + WS_WOUT + (size_t)l * 2 * MiB, lastl ? NLATR : NTOK, DM, F.G, F.bid, lastl ? NCTXR : 0);
            g8::EpiDelta E{(bf16_t*)(WSP(F) + WS_DELTA), (const float*)(WSP(F) + WS_MODV) + (size_t)(l * 5) * 6144 + 2 * 1024};
            g8::gemm_phase(F.lds, S, E);
            END(base + 5);
        }
        if (SEL(12) && IN(base + 6)) { phase_e(F, l); END(base + 6); }
        if (SEL(13) && IN(base + 7)) {
            moe_tstart_table(F, l);
            const LAS int* tab = (const LAS int*)(F.lds + TAB_OFF);
            g8::MoeSched<true> S{(const char*)(WSP(F) + WS_U), (const char*)(WSP(F) + WS_WGU) + (size_t)l * 32 * 2048 * 2048, (const int*)(WSP(F) + WS_SLOTTOK), tab, __builtin_amdgcn_readfirstlane(tab[64]) * 8, F.G, F.bid, nullptr};
            g8::EpiSwiglu E{(bf16_t*)(WSP(F) + WS_HDN), INP(F, I_BGU) + (size_t)l * 32 * 2048, ctl + CW_DEP + l * 512};
            g8::gemm_phase(F.lds, S, E);
        }
        if (SEL(14) && IN(base + 8)) {
#if MK_MULTI
            moe_tstart_table(F, l);
#endif
            const LAS int* tab = (const LAS int*)(F.lds + TAB_OFF);
            g8::MoeSched<false> S{(const char*)(WSP(F) + WS_HDN), (const char*)(WSP(F) + WS_WD) + (size_t)l * 32 * 1024 * 2048, (const int*)(WSP(F) + WS_SLOTTOK), tab, __builtin_amdgcn_readfirstlane(tab[64]) * 4, F.G, F.bid, ctl + CW_DEP + l * 512};
            g8::EpiDown E{(bf16_t*)(WSP(F) + WS_Y2), INP(F, I_BD) + (size_t)l * 32 * 1024};
            g8::gemm_phase(F.lds, S, E);
            END(base + 8);
        }
    }
    if (SEL(1) && IN(41)) phase_a(F, 4);
#if defined(DBG_STOP)
    if (lo == 100 && (long)DBG_DUMP_OFF >= 0) {
        const size_t n = (size_t)NLATR * DM; float* o = OUTP(F);
        for (size_t i = (size_t)F.bid * 512 + F.tid; i < n; i += (size_t)F.G * 512) {
            float acc = 0.f;
            for (size_t j = i; j < (size_t)DBG_DUMP_TOTAL; j += n) {
                if (DBG_DUMP_BF16) acc += bf2f(((const bf16_t*)(WSP(F) + (size_t)DBG_DUMP_OFF))[j]);
                else acc += ((const float*)(WSP(F) + (size_t)DBG_DUMP_OFF))[j]; }
            o[i] = acc;
        }
    }
#endif
#undef IN
#undef END
}

extern "C" void kernel_launch(void* const* d_in, const int* in_sizes, int n_in, void* d_out, int out_size, void* d_ws, size_t ws_size, hipStream_t stream) {
    static int ready = 0;
    if (ready == 0) {
        if (n_in != 28 || out_size != NLATR * DM || ws_size < WS_END) { fprintf(stderr, "kernel_launch: unexpected shapes (n_in %d out %d ws %zu)\n", n_in, out_size, ws_size); ready = -1; return; }
        if (hipFuncSetAttribute((const void*)mk_fwd, hipFuncAttributeMaxDynamicSharedMemorySize, LDS_BYTES) != hipSuccess) { fprintf(stderr, "kernel_launch: hipFuncSetAttribute failed\n"); ready = -1; return; }
        int per_cu = 0;
        if (hipOccupancyMaxActiveBlocksPerMultiprocessor(&per_cu, (const void*)mk_fwd, 512, LDS_BYTES) != hipSuccess || per_cu < 1)
            fprintf(stderr, "kernel_launch: occupancy query reports %d workgroups per CU\n", per_cu);
        (void)hipGetLastError();
        ready = 1;
    }
    if (ready < 0) return;
    (void)hipMemsetAsync((char*)d_ws + WS_CTL, 0, CTL_ZERO_BYTES, stream);
    Args a{};
    for (int i = 0; i < 28; ++i) a.in[i] = (const float*)d_in[i];
    a.out = (float*)d_out; a.ws = (unsigned char*)d_ws;
#if MK_MULTI
#if defined(DBG_STOP)
    for (int k = 0; k <= DBG_STOP; ++k) {
#else
    for (int k = 0; k < N_PHASES; ++k) {
#endif
        const int l = (k - 1) / 10, j = (k - 1) % 10;
        if (k > 0 && k < 41) { if (j == 9) continue; if (j == 4 && (l % 3) == 1) continue; }
        a.ph_lo = k; a.ph_hi = k + 1;
        hipLaunchKernelGGL(mk_fwd, dim3(256), dim3(512), LDS_BYTES, stream, a);
    }
#if defined(DBG_STOP)
    a.ph_lo = 100; a.ph_hi = 101;
    hipLaunchKernelGGL(mk_fwd, dim3(256), dim3(512), LDS_BYTES, stream, a);
#endif
#else
    a.ph_lo = 0; a.ph_hi = N_PHASES;
    hipLaunchKernelGGL(mk_fwd, dim3(256), dim3(512), LDS_BYTES, stream, a);
#endif
    const hipError_t le = hipPeekAtLastError();
    if (le != hipSuccess) fprintf(stderr, "kernel_launch: launch failed: %s\n", hipGetErrorName(le));
}
```

```cpp
#include <hip/hip_runtime.h>
#include <cstdio>
#include <cstdint>
#include <cstddef>

#ifndef MK_MULTI
#define MK_MULTI 0
#endif

#define GAS __attribute__((address_space(1)))
#define LAS __attribute__((address_space(3)))
typedef unsigned short bf16_t;
typedef short bf16x8 __attribute__((ext_vector_type(8)));
typedef float f32x4 __attribute__((ext_vector_type(4)));
typedef float f32x2 __attribute__((ext_vector_type(2)));
typedef unsigned u32x4 __attribute__((ext_vector_type(4)));
typedef unsigned u32x2 __attribute__((ext_vector_type(2)));

constexpr int DM = 1024, NBATCH = 4, SEQ = 4096, CTXL = 256, DEPTH = 4;
constexpr int NCTXR = NBATCH * CTXL;
constexpr int NLATR = NBATCH * SEQ;
constexpr int NTOK = NCTXR + NLATR;
constexpr int NEXP = 32, TOPK = 4;
constexpr int NPAD_A = 3328, NPAD_B = 2048;
constexpr int MAXTILES = 304;
constexpr float NORM_EPS = 1e-6f;

constexpr size_t MiB = 1u << 20;
constexpr size_t WS_CTL = 0, CTL_ZERO_BYTES = 1 * MiB;
constexpr size_t WS_MODV = 1 * MiB;
constexpr size_t WS_ROUTW = 3 * MiB;
constexpr size_t WS_TOKREC = 4 * MiB;
constexpr size_t WS_SLOTTOK = 5 * MiB;
constexpr size_t WS_HCTX = 8 * MiB;
constexpr size_t WS_GATES = 360 * MiB;
constexpr size_t WS_WIN = 16 * MiB;
constexpr size_t WS_WOUT = 48 * MiB;
constexpr size_t WS_U = 64 * MiB;
constexpr size_t WS_P = 128 * MiB;
constexpr size_t WS_AUX = 240 * MiB;
constexpr size_t WS_HDIR = 400 * MiB;
constexpr size_t WS_DELTA = WS_HDIR;
constexpr size_t WS_YPRE = 480 * MiB;
constexpr size_t WS_HDN = 520 * MiB;
constexpr size_t WS_Y2 = 680 * MiB;
constexpr size_t WS_WGU = 1024 * MiB;
constexpr size_t WS_WD = 1536 * MiB;
constexpr size_t WS_END = 1792 * MiB;
constexpr size_t AUX_QK = 0;
constexpr size_t AUX_KB = 40 * MiB;
constexpr size_t AUX_VB = 60 * MiB;
constexpr size_t AUX_QT = 0;
constexpr size_t AUX_KT = 36 * MiB;
constexpr size_t AUX_KHT = 72 * MiB;
constexpr size_t AUX_DEC = 108 * MiB;
constexpr int CW_BAR = 4096;
constexpr int CW_CNT = 16384;

constexpr int LDS_BYTES = 147456;
constexpr int TAB_OFF = 131072;
constexpr int MISC_OFF = LDS_BYTES - 16;

typedef __bf16 bf16x2_t __attribute__((ext_vector_type(2)));
__device__ __forceinline__ unsigned cvt_pk_bf16(float lo, float hi) { f32x2 v = {lo, hi}; bf16x2_t r = __builtin_convertvector(v, bf16x2_t); return __builtin_bit_cast(unsigned, r); }
__device__ __forceinline__ bf16_t f2bf(float f) { return (bf16_t)(cvt_pk_bf16(f, 0.f) & 0xffffu); }
__device__ __forceinline__ float bf2f(bf16_t b) { return __uint_as_float(((unsigned)b) << 16); }
__device__ __forceinline__ float bflo(unsigned w) { return __uint_as_float(w << 16); }
__device__ __forceinline__ float bfhi(unsigned w) { return __uint_as_float(w & 0xffff0000u); }
__device__ __forceinline__ float shx(float v, int mask, int lane) { return __int_as_float(__builtin_amdgcn_ds_bpermute((lane ^ mask) << 2, __float_as_int(v))); }
__device__ __forceinline__ int shxi(int v, int mask, int lane) { return __builtin_amdgcn_ds_bpermute((lane ^ mask) << 2, v); }
__device__ __forceinline__ float shup(float v, int d, int lane) { const int src = lane >= d ? lane - d : lane; return __int_as_float(__builtin_amdgcn_ds_bpermute(src << 2, __float_as_int(v))); }
__device__ __forceinline__ float shdn(float v, int d, int lane) { const int src = lane + d < 64 ? lane + d : lane; return __int_as_float(__builtin_amdgcn_ds_bpermute(src << 2, __float_as_int(v))); }
__device__ __forceinline__ float shidx(float v, int src) { return __int_as_float(__builtin_amdgcn_ds_bpermute(src << 2, __float_as_int(v))); }
template <int CTRL> __device__ __forceinline__ float dpp(float x) { return __builtin_bit_cast(float, __builtin_amdgcn_mov_dpp(__builtin_bit_cast(int, x), CTRL, 0xf, 0xf, true)); }
constexpr int DPP_XOR1 = 0xB1, DPP_XOR2 = 0x4E, DPP_XOR7 = 0x141, DPP_XOR8 = 0x128, DPP_ROR4 = 0x124, DPP_XOR3 = 0x1B;
__device__ __forceinline__ float row16_sum(float x) { x += dpp<DPP_XOR1>(x); x += dpp<DPP_XOR2>(x); x += dpp<DPP_ROR4>(x); x += dpp<DPP_XOR8>(x); return x; }
__device__ __forceinline__ float half_sum(float x) {
    x = row16_sum(x); auto s_ = __builtin_amdgcn_permlane16_swap(__float_as_uint(x), __float_as_uint(x), false, false); return __uint_as_float(s_[0]) + __uint_as_float(s_[1]); }
__device__ __forceinline__ float wave_sum(float x, int) {
    x = half_sum(x); auto t_ = __builtin_amdgcn_permlane32_swap(__float_as_uint(x), __float_as_uint(x), false, false); return __uint_as_float(t_[0]) + __uint_as_float(t_[1]); }
template <int M> __device__ __forceinline__ float xch(float x, int lane) {
    if constexpr (M == 1) return dpp<DPP_XOR1>(x);
    else if constexpr (M == 2) return dpp<DPP_XOR2>(x);
    else if constexpr (M == 4) return dpp<DPP_XOR3>(dpp<DPP_XOR7>(x));
    else if constexpr (M == 8) return dpp<DPP_XOR8>(x);
    else if constexpr (M == 16) { auto s_ = __builtin_amdgcn_permlane16_swap(__float_as_uint(x), __float_as_uint(x), false, false); return __uint_as_float((lane & 16) ? s_[0] : s_[1]); }
    else { auto s_ = __builtin_amdgcn_permlane32_swap(__float_as_uint(x), __float_as_uint(x), false, false); return __uint_as_float((lane & 32) ? s_[0] : s_[1]); }
}
__device__ __forceinline__ float sigmoidf_(float x) { return __builtin_amdgcn_rcpf(1.f + __builtin_amdgcn_exp2f(-1.4426950408889634f * x)); }
__device__ __forceinline__ float logsigmoidf_(float x) { return fminf(x, 0.f) - __logf(1.f + __expf(-fabsf(x))); }
#define LDS_WAIT() asm volatile("s_waitcnt lgkmcnt(0)" ::: "memory")
#define VM_WAIT() asm volatile("s_waitcnt vmcnt(0)" ::: "memory")

#define XB_TMO      128
#define XB_XCNT(j)  (256  + 64 * (j))
#define XB_XSUB(j)  (1280 + 64 * (j))
#define XB_XGEN(j)  (2304 + 64 * (j))
#define XB_TOP      3328
#define XB_TOPGEN   3392
#define XCD_BAR_WORDS 3456
#define XB_SPIN_CAP (1u << 18)

__device__ __forceinline__ unsigned xb_ld(unsigned* p)              { return __hip_atomic_load(p, __ATOMIC_RELAXED, __HIP_MEMORY_SCOPE_AGENT); }
__device__ __forceinline__ unsigned xb_add(unsigned* p, unsigned v) { return __hip_atomic_fetch_add(p, v, __ATOMIC_RELAXED, __HIP_MEMORY_SCOPE_AGENT); }
__device__ __forceinline__ unsigned xb_xcc_id() { return (unsigned)__builtin_amdgcn_s_getreg((3 << 11) | 20) & 0xFu; }
#define XB_SPIN(cond, bar) do { unsigned _sp = 0; while (cond) { __builtin_amdgcn_s_sleep(1); \
    if ((++_sp & 255u) == 0u) { if (xb_ld(&(bar)[XB_TMO])) break; if (_sp > XB_SPIN_CAP) { atomicAdd(&(bar)[XB_TMO], 1u); break; } } } } while (0)

__device__ __forceinline__ int lane_now() { int l; asm volatile("v_mbcnt_lo_u32_b32 %0, -1, 0\n\tv_mbcnt_hi_u32_b32 %0, -1, %0" : "=v"(l)); return l; }
struct XcdBarrier { unsigned* bar; unsigned x; volatile LAS unsigned* st; int wave; };

__device__ __forceinline__ XcdBarrier xcd_barrier_post(unsigned* bar, volatile LAS unsigned* st, int wave) {
    XcdBarrier b; b.bar = bar; b.x = xb_xcc_id(); b.st = st; b.wave = wave;
    if (wave == 0 && lane_now() == 0) (void)xb_add(&bar[XB_XCNT(b.x)], 1u);
    return b;
}
__device__ __forceinline__ void xcd_barrier_complete(unsigned* bar, unsigned x, unsigned& nloc, unsigned& nx) {
    const unsigned G = gridDim.x * gridDim.y * gridDim.z;
    unsigned sum, cnt, mine, sp = 0u;
    for (;;) {
        sum = 0u; cnt = 0u; mine = 0u;
#pragma unroll
        for (unsigned j = 0; j < 16; ++j) { const unsigned c = xb_ld(&bar[XB_XCNT(j)]); sum += c; cnt += (c > 0u) ? 1u : 0u; mine = (j == x) ? c : mine; }
        if (sum == G) break;
        __builtin_amdgcn_s_sleep(1);
        if ((++sp & 255u) == 0u) { if (xb_ld(&bar[XB_TMO])) break; if (sp > XB_SPIN_CAP) { atomicAdd(&bar[XB_TMO], 1u); break; } }
    }
    nloc = mine > 0u ? mine : 1u; nx = cnt > 0u ? cnt : 1u;
}
__device__ __forceinline__ void xcd_barrier(const XcdBarrier& b) {
    asm volatile("s_waitcnt vmcnt(0)" ::: "memory");
    __syncthreads();
    if (b.wave == 0 && lane_now() == 0) {
        unsigned* bar = b.bar;
        __builtin_amdgcn_s_waitcnt(0);
        unsigned nloc = b.st[0], nx = b.st[1];
        if (nloc == 0u) { xcd_barrier_complete(bar, b.x, nloc, nx); b.st[0] = nloc; b.st[1] = nx; }
        const unsigned old = xb_add(&bar[XB_XSUB(b.x)], 1u);
        const unsigned gen = old / nloc;
        if (old + 1u == (gen + 1u) * nloc) {
            __builtin_amdgcn_fence(__ATOMIC_RELEASE, "agent");
            asm volatile("s_waitcnt vmcnt(0)" ::: "memory");
            const unsigned og = xb_add(&bar[XB_TOP], 1u);
            const unsigned tg = og / nx;
            if (og + 1u == (tg + 1u) * nx) xb_add(&bar[XB_TOPGEN], 1u);
            else XB_SPIN(xb_ld(&bar[XB_TOPGEN]) == tg, bar);
            __builtin_amdgcn_fence(__ATOMIC_ACQUIRE, "agent");
            xb_add(&bar[XB_XGEN(b.x)], 1u);
            asm volatile("s_waitcnt vmcnt(0)" ::: "memory");
        } else {
            XB_SPIN(xb_ld(&bar[XB_XGEN(b.x)]) == gen, bar);
            __builtin_amdgcn_fence(__ATOMIC_ACQUIRE, "agent");
            asm volatile("s_waitcnt vmcnt(0)" ::: "memory");
        }
    }
    __syncthreads();
}

#define CAS __attribute__((address_space(4)))
typedef const float* cfp_t;
struct Args { const float* in[28]; float* out; unsigned char* ws; int ph_lo, ph_hi; };
static_assert(offsetof(Args, in) == 0 && offsetof(Args, out) == 224 && offsetof(Args, ws) == 232 && offsetof(Args, ph_lo) == 240 && sizeof(Args) == 248, "Args layout (the kernel reads the kernarg segment by offset)");
struct Frame {
    LAS unsigned char* lds;
    int tid, lane, wave, G, bid;
    const CAS char* ka; GAS float* out_; GAS unsigned char* ws_;
};
enum { I_X = 0, I_C, I_CTX, I_CCTX, I_N1G, I_N2G, I_MODW, I_MODB, I_MWIN, I_MCONV, I_MGB, I_MNG, I_MWOUT, I_AWIN, I_AQG, I_AKG, I_AWOUT,
       I_GWIN, I_GAW2, I_GAB, I_GNG, I_GWOUT, I_RW, I_RB, I_WGU, I_BGU, I_WD, I_BD };

#define INP(F, k) ((const float*)(((const GAS float* const CAS*)(F).ka)[k]))
#define WSP(F) ((unsigned char*)(F).ws_)
#define OUTP(F) ((float*)(F).out_)
__device__ __forceinline__ Frame refresh(const Frame& F0) {
    Frame L = F0; int t = F0.wave * 64 + lane_now(); asm volatile("" : "+v"(t)); L.tid = t; L.lane = t & 63; L.wave = __builtin_amdgcn_readfirstlane(t >> 6);
    return L;
}

constexpr float Q8_W = 512.f, Q8_U = 4.f, Q8_H = 4.f;
__device__ __forceinline__ unsigned pk4_fp8(float a, float b, float c, float d, float S) {
    a = __builtin_amdgcn_fmed3f(a * S, -448.f, 448.f); b = __builtin_amdgcn_fmed3f(b * S, -448.f, 448.f); c = __builtin_amdgcn_fmed3f(c * S, -448.f, 448.f); d = __builtin_amdgcn_fmed3f(d * S, -448.f, 448.f);
    int w = __builtin_amdgcn_cvt_pk_fp8_f32(a, b, 0, false);
    w = __builtin_amdgcn_cvt_pk_fp8_f32(c, d, w, true);
    return (unsigned)w;
}
namespace g8 {
constexpr int BM = 256, BK = 64, HALF = 128, HTB = HALF * BK * 2, STAGE_BYTES = 8 * HTB, NXCD = 8, WGM = 8;
constexpr int K = 1024;
constexpr unsigned HSTEP = (unsigned)HALF * K * 2;
constexpr size_t TSTEP = 2 * (size_t)HSTEP;

__device__ __forceinline__ int lds_byte(int r, int c) { const int st = (r >> 4) * 2 + (c >> 5), rr = r & 15, cc = c & 31, ob = rr * 64 + cc * 2; return st * 1024 + (ob ^ (((ob >> 9) & 1) << 5)); }
__device__ __forceinline__ void stage_rc(int b, int& R, int& C) { const int st = b / 1024, sb = b % 1024, swz = sb ^ (((sb >> 9) & 1) << 5); R = (st >> 1) * 16 + swz / 64; C = (st & 1) * 32 + (swz % 64) / 2; }
__device__ __forceinline__ int perm32(int rho) { const int n = rho >> 4, i = rho & 15; return 8 * (i >> 2) + 4 * n + (i & 3); }

typedef int i32x4_t __attribute__((ext_vector_type(4)));
typedef int i32x8_t __attribute__((ext_vector_type(8)));
__device__ __forceinline__ i32x8_t cat8(bf16x8 a, bf16x8 b) { const i32x4_t x = __builtin_bit_cast(i32x4_t, a), y = __builtin_bit_cast(i32x4_t, b); return __builtin_shufflevector(x, y, 0, 1, 2, 3, 4, 5, 6, 7); }
struct Unit { const char* a; const char* b0; const char* b1; int orow; int ocol; int e; int aux; };

struct StaticSched {
    const char* A; const char* Bt; int nM, nN, nwg, G, c, row_off;
    __device__ __forceinline__ void init(const void* A_, const void* Bt_, int M, int N, int G_, int c_, int row_off_ = 0) { A = (const char*)A_ + (size_t)row_off_ * (K * 2); Bt = (const char*)Bt_; nM = M / BM; nN = N / BM; nwg = nM * nN; G = G_; c = c_; row_off = row_off_; }
    __device__ __forceinline__ bool next(int i, Unit& u) const {
        const long L = (long)i * G + c; if (L >= nwg) return false;
        int wgid = (int)L; { const int q = nwg / NXCD, r = nwg % NXCD, xcd = wgid % NXCD, off = wgid / NXCD; wgid = (xcd < r ? xcd * (q + 1) : r * (q + 1) + (xcd - r) * q) + off; }
        const int nig = WGM * nN, gid = wgid / nig, fm = gid * WGM, gsz = (nM - fm) < WGM ? (nM - fm) : WGM;
        const int pm = fm + ((wgid % nig) % gsz), pn = (wgid % nig) / gsz;
        u.a = A + (size_t)pm * TSTEP; u.b0 = Bt + (size_t)pn * TSTEP; u.b1 = u.b0 + HSTEP; u.orow = row_off + pm * BM; u.ocol = pn * BM; u.e = 0; u.aux = 0; return true;
    }
    static constexpr bool GATHER = false, FP8 = false;
    __device__ __forceinline__ int zero() const { return nwg >> 30; }
    __device__ __forceinline__ void a_rows(const Unit&, const unsigned (&)[2], unsigned (&)[2], __amdgpu_buffer_rsrc_t, const char*) const {}
};
template <bool GU> struct MoeSched {
    const char* A; const char* W; const int* slottok; const LAS int* tab; int nunits, G, c;
    static constexpr int NPN = GU ? 8 : 4;
    __device__ __forceinline__ bool next(int i, Unit& u) const {
        constexpr int TL = 32 / NPN;
        const int x = c & 7, j = c >> 3, T = (i * 8 + x) * TL + j / NPN, pn = j % NPN;
        if (T * NPN >= nunits) return false;
        const int e = __builtin_amdgcn_readfirstlane(tab[80 + T]);
        u.e = e; u.orow = T * BM; u.ocol = pn; u.aux = (T - __builtin_amdgcn_readfirstlane(tab[32 + e])) * BM;
        if (GU) { u.a = A; u.b0 = W + (size_t)e * (2048u * 1024u) + (size_t)pn * (HSTEP / 2); u.b1 = u.b0 + (size_t)1024 * 1024; }
        else { u.a = A + (size_t)T * (TSTEP / 2); u.b0 = W + (size_t)e * (1024u * 1024u) + (size_t)pn * (TSTEP / 2); u.b1 = u.b0 + HSTEP / 2; }
        return true;
    }
    __device__ __forceinline__ int zero() const { return nunits >> 30; }
    static constexpr bool GATHER = GU, FP8 = true;
    __device__ __forceinline__ void a_rows(const Unit& u, const unsigned (&sv)[2], unsigned (&tk)[2], __amdgpu_buffer_rsrc_t rs, const char* wsb) const {
        const int cnt = __builtin_amdgcn_readfirstlane(tab[u.e]);
        const int sbase = (int)(unsigned)((const char*)(slottok + u.e * NTOK) - wsb);
        int r0 = (int)(sv[0] >> 10), r1 = (int)(sv[1] >> 10);
        asm volatile("" : "+v"(r0), "+v"(r1));
#pragma unroll
        for (int h = 0; h < 2; ++h) {
            const int s0 = u.aux + h * HALF + r0, s1 = u.aux + h * HALF + r1;
            const int l0 = __builtin_amdgcn_raw_buffer_load_b32(rs, s0 * 4, sbase, 0), l1 = __builtin_amdgcn_raw_buffer_load_b32(rs, s1 * 4, sbase, 0);
            const int t0 = (s0 < cnt) ? l0 : 0, t1 = (s1 < cnt) ? l1 : 0;
            tk[h] = (unsigned)t0 | ((unsigned)t1 << 16);
        }
    }
};

struct EpiBf16 {
    static constexpr bool PERM = true, PRE = false;
    bf16_t* O; int ldc;
    __device__ __forceinline__ void operator()(const f32x4 (&acc)[2][2][4][2], const Unit& u, int wr, int wc, int fr, int fq) const {
        const int row0 = u.orow + wr * 64 + fr, col0 = u.ocol + wc * 32 + 8 * fq;
#pragma unroll
        for (int ai = 0; ai < 2; ++ai)
#pragma unroll
            for (int m = 0; m < 4; ++m) { bf16_t* rowp = O + (size_t)(row0 + ai * HALF + m * 16) * ldc + col0;
#pragma unroll
                for (int bj = 0; bj < 2; ++bj) { const f32x4 v0 = acc[ai][bj][m][0], v1 = acc[ai][bj][m][1];
                    u32x4 w; w.x = cvt_pk_bf16(v0[0], v0[1]); w.y = cvt_pk_bf16(v0[2], v0[3]); w.z = cvt_pk_bf16(v1[0], v1[1]); w.w = cvt_pk_bf16(v1[2], v1[3]);
                    *(u32x4*)(rowp + bj * HALF) = w; } }
    }
};
struct EpiDelta {
    static constexpr bool PERM = true, PRE = true;
    bf16_t* O; const float* mod2;
    __device__ __forceinline__ void prefetch(const Unit& u, LAS unsigned char* aux, int lane) const {
        const int r = u.orow < NCTXR ? 4 : ((u.orow - NCTXR) >> 12);
        __builtin_amdgcn_global_load_lds((const unsigned*)(mod2 + r * 6144 + u.ocol + lane * 4), (LAS unsigned*)aux, 16, 0, 0);
    }
    __device__ __forceinline__ void operator()(const f32x4 (&acc)[2][2][4][2], const Unit& u, int wr, int wc, int fr, int fq, const LAS unsigned char* aux) const {
        const int row0 = u.orow + wr * 64 + fr, cu = wc * 32 + 8 * fq, col0 = u.ocol + cu;
        f32x4 mv[2][2];
#pragma unroll
        for (int bj = 0; bj < 2; ++bj)
#pragma unroll
            for (int n = 0; n < 2; ++n) mv[bj][n] = *(const LAS f32x4*)(aux + (bj * HALF + cu + 4 * n) * 4);
#pragma unroll
        for (int ai = 0; ai < 2; ++ai)
#pragma unroll
            for (int m = 0; m < 4; ++m) { bf16_t* rowp = O + (size_t)(row0 + ai * HALF + m * 16) * DM + col0;
#pragma unroll
                for (int bj = 0; bj < 2; ++bj) { const f32x4 v0 = acc[ai][bj][m][0] * mv[bj][0], v1 = acc[ai][bj][m][1] * mv[bj][1];
                    u32x4 w; w.x = cvt_pk_bf16(v0[0], v0[1]); w.y = cvt_pk_bf16(v0[2], v0[3]); w.z = cvt_pk_bf16(v1[0], v1[1]); w.w = cvt_pk_bf16(v1[2], v1[3]);
                    *(u32x4*)(rowp + bj * HALF) = w; } }
    }
};
struct EpiSwiglu {
    static constexpr bool PERM = true, PRE = true;
    unsigned char* H; const float* bgu;
    __device__ __forceinline__ void prefetch(const Unit& u, LAS unsigned char* aux, int lane) const {
        const float* g = bgu + u.e * 2048 + u.ocol * 128 + (lane >> 5) * 1024 + (lane & 31) * 4;
        __builtin_amdgcn_global_load_lds((const unsigned*)g, (LAS unsigned*)aux, 16, 0, 0);
    }
    __device__ __forceinline__ void operator()(const f32x4 (&acc)[2][2][4][2], const Unit& u, int wr, int wc, int fr, int fq, const LAS unsigned char* aux) const {
        const int row0 = u.orow + wr * 64 + fr, cl = wc * 32 + 8 * fq, col0 = u.ocol * 128 + cl;
        f32x4 bg[2], bl[2];
#pragma unroll
        for (int n = 0; n < 2; ++n) { bg[n] = *(const LAS f32x4*)(aux + (cl + 4 * n) * 4); bl[n] = *(const LAS f32x4*)(aux + 512 + (cl + 4 * n) * 4); }
#pragma unroll
        for (int ai = 0; ai < 2; ++ai)
#pragma unroll
            for (int m = 0; m < 4; ++m) {
                float o[8];
#pragma unroll
                for (int n = 0; n < 2; ++n) { const f32x4 gv = acc[ai][0][m][n] * (1.f / (Q8_U * Q8_W)) + bg[n], lv = acc[ai][1][m][n] * (1.f / (Q8_U * Q8_W)) + bl[n];
#pragma unroll
                    for (int j = 0; j < 4; ++j) { const float g = fminf(gv[j], 7.f), li = fminf(fmaxf(lv[j], -7.f), 7.f);
                        o[n * 4 + j] = g * (li + 1.f) * __builtin_amdgcn_rcpf(1.f + __builtin_amdgcn_exp2f(-2.4554669595930156f * g)); } }
                u32x2 w; w.x = pk4_fp8(o[0], o[1], o[2], o[3], Q8_H); w.y = pk4_fp8(o[4], o[5], o[6], o[7], Q8_H);
                *(u32x2*)(H + (size_t)(row0 + ai * HALF + m * 16) * DM + col0) = w; }
    }
};
struct EpiDown {
    static constexpr bool PERM = true, PRE = true;
    bf16_t* Y; const float* bd;
    __device__ __forceinline__ void prefetch(const Unit& u, LAS unsigned char* aux, int lane) const {
        __builtin_amdgcn_global_load_lds((const unsigned*)(bd + u.e * 1024 + u.ocol * 256 + lane * 4), (LAS unsigned*)aux, 16, 0, 0);
    }
    __device__ __forceinline__ void operator()(const f32x4 (&acc)[2][2][4][2], const Unit& u, int wr, int wc, int fr, int fq, const LAS unsigned char* aux) const {
        const int row0 = u.orow + wr * 64 + fr, cu = wc * 32 + 8 * fq, col0 = u.ocol * 256 + cu;
        f32x4 bv[2][2];
#pragma unroll
        for (int bj = 0; bj < 2; ++bj)
#pragma unroll
            for (int n = 0; n < 2; ++n) bv[bj][n] = *(const LAS f32x4*)(aux + (bj * HALF + cu + 4 * n) * 4);
#pragma unroll
        for (int ai = 0; ai < 2; ++ai)
#pragma unroll
            for (int m = 0; m < 4; ++m) { bf16_t* rowp = Y + (size_t)(row0 + ai * HALF + m * 16) * DM + col0;
#pragma unroll
                for (int bj = 0; bj < 2; ++bj) { const f32x4 v0 = acc[ai][bj][m][0] * (1.f / (Q8_H * Q8_W)) + bv[bj][0], v1 = acc[ai][bj][m][1] * (1.f / (Q8_H * Q8_W)) + bv[bj][1];
                    u32x4 w; w.x = cvt_pk_bf16(v0[0], v0[1]); w.y = cvt_pk_bf16(v0[2], v0[3]); w.z = cvt_pk_bf16(v1[0], v1[1]); w.w = cvt_pk_bf16(v1[2], v1[3]);
                    *(u32x4*)(rowp + bj * HALF) = w; } }
    }
};

template <class Epi, class Sched>
__device__ __forceinline__ void gemm_phase(LAS unsigned char* lds, const Sched& S, const Epi& E, const char* wsb, int wv) {
    const __amdgpu_buffer_rsrc_t rs = __builtin_amdgcn_make_buffer_rsrc((void*)wsb, 0, 0x7fffffff, 0x00020000);
    int tz = wv * 64 + lane_now(); asm volatile("" : "+v"(tz));
    const int tid = tz, wid = __builtin_amdgcn_readfirstlane(tid >> 6), lane = tid & 63, wr = wid >> 2, wc = wid & 3, fr = lane & 15, fq = lane >> 4;
    constexpr bool FP8 = Sched::FP8;
    constexpr int RS = FP8 ? 1024 : 2048;
    constexpr unsigned HS = 128u * RS;
    const int nt = (FP8 ? 8 : K / BK) + S.zero();
    constexpr bool GATHER = Sched::GATHER;
    unsigned svA[2], voffB[2];
#pragma unroll
    for (int i = 0; i < 2; ++i) { int R, C; stage_rc(tid * 16 + i * 8192, R, C); const int Rb = Epi::PERM ? ((R & ~31) + perm32(R & 31)) : R;
        svA[i] = (unsigned)(R * RS + C * 2); voffB[i] = (unsigned)(Rb * RS + C * 2); }
    constexpr size_t kstep = (size_t)(BK * 2);
    const unsigned ldsw = (unsigned)wid * 1024u;
    const int aoff = lds_byte(wr * 64 + fr, fq * 8), boff = lds_byte(wc * 32 + fr, fq * 8);
#define G8_SA(b, h) (((b) * 2 + (h)) * HTB)
#define G8_SB(b, h) ((4 + (b) * 2 + (h)) * HTB)
#define G8_STAGE2(bufoff, gbase, v0, v1) do { const int _so = (int)(unsigned)((const char*)(gbase) - wsb); \
        __builtin_amdgcn_raw_ptr_buffer_load_lds(rs, (LAS unsigned*)(lds + (bufoff) + ldsw), 16, (int)(v0), _so, 0, 0); \
        __builtin_amdgcn_raw_ptr_buffer_load_lds(rs, (LAS unsigned*)(lds + (bufoff) + ldsw + 8192), 16, (int)(v1), _so, 0, 0); } while (0)
#define G8_STAGE_A(bufoff, gbase, h, tk) do { if constexpr (GATHER) { const unsigned _t = (tk)[h]; \
            G8_STAGE2(bufoff, gbase, (_t & 0xffffu) * (unsigned)RS + (svA[0] & (unsigned)(RS - 1)), (_t >> 16) * (unsigned)RS + (svA[1] & (unsigned)(RS - 1))); } \
        else { G8_STAGE2(bufoff, (gbase) + (h) * HS, svA[0], svA[1]); } } while (0)
#define G8_LDA(dst, b, h) do { _Pragma("unroll") for (int m = 0; m < 4; ++m) _Pragma("unroll") for (int k = 0; k < 2; ++k) dst[m][k] = *(const LAS bf16x8*)(lds + G8_SA(b, h) + aoff + m * 2048 + k * 1024); } while (0)
#define G8_LDB(dst, b, h) do { _Pragma("unroll") for (int n = 0; n < 2; ++n) _Pragma("unroll") for (int k = 0; k < 2; ++k) dst[n][k] = *(const LAS bf16x8*)(lds + G8_SB(b, h) + boff + n * 2048 + k * 1024); } while (0)
#define G8_MMA(ai, bj, At, Bt) do { __builtin_amdgcn_s_setprio(1); _Pragma("unroll") for (int m = 0; m < 4; ++m) _Pragma("unroll") for (int n = 0; n < 2; ++n) { \
        if constexpr (FP8) acc[ai][bj][m][n] = __builtin_amdgcn_mfma_scale_f32_16x16x128_f8f6f4(cat8(Bt[n][0], Bt[n][1]), cat8(At[m][0], At[m][1]), acc[ai][bj][m][n], 0, 0, 0, 0, 0, 0); \
        else { _Pragma("unroll") for (int k = 0; k < 2; ++k) acc[ai][bj][m][n] = __builtin_amdgcn_mfma_f32_16x16x32_bf16(Bt[n][k], At[m][k], acc[ai][bj][m][n], 0, 0, 0); } } \
        __builtin_amdgcn_s_setprio(0); } while (0)
#define G8_WAIT_V(n) asm volatile("s_waitcnt vmcnt(" #n ")" ::: "memory")
#define G8_WAIT_L(n) asm volatile("s_waitcnt lgkmcnt(" #n ")" ::: "memory")
#define G8_BAR __builtin_amdgcn_s_barrier()
#define G8_SCHED __builtin_amdgcn_sched_barrier(0)
    Unit cur, nxt; int ui = 0;
    if (!S.next(0, cur)) return;
    LAS unsigned char* const auxb = lds + (TAB_OFF + 2048);
    if constexpr (Epi::PRE) { if (wid == 0) E.prefetch(cur, auxb, lane_now()); }
    unsigned ctk[2] = {0u, 0u}, ntk[2] = {0u, 0u};
    if constexpr (GATHER) S.a_rows(cur, svA, ctk, rs, wsb);
    f32x4 acc[2][2][4][2];
#pragma unroll
    for (int a = 0; a < 2; ++a)
#pragma unroll
        for (int b = 0; b < 2; ++b)
#pragma unroll
            for (int m = 0; m < 4; ++m)
#pragma unroll
                for (int n = 0; n < 2; ++n) acc[a][b][m][n] = (f32x4){0.f, 0.f, 0.f, 0.f};
    bf16x8 At[4][2], B0[2][2], B1[2][2];
    const char* cA = cur.a; const char* cB0 = cur.b0; const char* cB1 = cur.b1;
    G8_STAGE2(G8_SB(0, 0), cB0, voffB[0], voffB[1]); G8_STAGE_A(G8_SA(0, 0), cA, 0, ctk); G8_STAGE2(G8_SB(0, 1), cB1, voffB[0], voffB[1]); G8_STAGE_A(G8_SA(0, 1), cA, 1, ctk);
    if (wr == 1) G8_BAR;
    G8_WAIT_V(4); G8_BAR;
    G8_STAGE2(G8_SB(1, 0), cB0 + kstep, voffB[0], voffB[1]); G8_STAGE_A(G8_SA(1, 0), cA + kstep, 0, ctk); G8_STAGE2(G8_SB(1, 1), cB1 + kstep, voffB[0], voffB[1]);
    G8_WAIT_V(6); G8_BAR;
    for (;;) {
        const bool has_next = S.next(ui + 1, nxt);
        const char* nA = has_next ? nxt.a : cA; const char* nB0 = has_next ? nxt.b0 : cB0; const char* nB1 = has_next ? nxt.b1 : cB1;
        ntk[0] = ctk[0]; ntk[1] = ctk[1];
#pragma nounroll
        for (int t = 0; t < nt; t += 2) {
            const bool last = (t == nt - 2);
            if constexpr (GATHER) { if (t == nt - 4 && has_next) S.a_rows(nxt, svA, ntk, rs, wsb); }
            const char* a1 = cA + (size_t)(t + 1) * kstep;
            const char* a2 = last ? nA : cA + (size_t)(t + 2) * kstep;
            const char* b20 = last ? nB0 : cB0 + (size_t)(t + 2) * kstep; const char* b21 = last ? nB1 : cB1 + (size_t)(t + 2) * kstep;
            const char* a3 = a2 + kstep; const char* b30 = b20 + kstep; const char* b31 = b21 + kstep;
            G8_LDB(B0, 0, 0); G8_SCHED; G8_LDA(At, 0, 0); G8_STAGE_A(G8_SA(1, 1), a1, 1, ctk);
            if constexpr (GATHER) { if (last) { ctk[0] = ntk[0]; ctk[1] = ntk[1]; } }
            G8_WAIT_L(8); G8_BAR; G8_WAIT_L(0); G8_MMA(0, 0, At, B0); G8_BAR; G8_SCHED;
            G8_LDB(B1, 0, 1); G8_STAGE2(G8_SB(0, 0), b20, voffB[0], voffB[1]);
            G8_BAR; G8_WAIT_L(0); G8_MMA(0, 1, At, B1); G8_BAR;
            G8_LDA(At, 0, 1); G8_STAGE_A(G8_SA(0, 0), a2, 0, ctk);
            G8_BAR; G8_WAIT_L(0); G8_MMA(1, 0, At, B0); G8_BAR; G8_SCHED;
            G8_STAGE2(G8_SB(0, 1), b21, voffB[0], voffB[1]);
            G8_WAIT_V(6); G8_BAR; G8_MMA(1, 1, At, B1); G8_BAR;
            G8_LDB(B0, 1, 0); G8_SCHED; G8_LDA(At, 1, 0); G8_STAGE_A(G8_SA(0, 1), a2, 1, ctk);
            G8_WAIT_L(8); G8_BAR; G8_WAIT_L(0); G8_MMA(0, 0, At, B0); G8_BAR; G8_SCHED;
            G8_LDB(B1, 1, 1); G8_STAGE2(G8_SB(1, 0), b30, voffB[0], voffB[1]);
            G8_BAR; G8_WAIT_L(0); G8_MMA(0, 1, At, B1); G8_BAR;
            G8_LDA(At, 1, 1); G8_STAGE_A(G8_SA(1, 0), a3, 0, ctk);
            G8_BAR; G8_WAIT_L(0); G8_MMA(1, 0, At, B0); G8_BAR; G8_SCHED;
            G8_STAGE2(G8_SB(1, 1), b31, voffB[0], voffB[1]);
            G8_WAIT_V(6); G8_BAR; G8_MMA(1, 1, At, B1); G8_BAR;
        }
        { int t2 = lane_now(); asm volatile("" : "+v"(t2)); const int l2 = t2 & 63;
          if constexpr (Epi::PRE) E(acc, cur, wr, wc, l2 & 15, l2 >> 4, auxb + (ui & 1) * 1024); else E(acc, cur, wr, wc, l2 & 15, l2 >> 4); }
        if (!has_next) break;
#pragma unroll
        for (int a = 0; a < 2; ++a)
#pragma unroll
            for (int b = 0; b < 2; ++b)
#pragma unroll
                for (int m = 0; m < 4; ++m)
#pragma unroll
                    for (int n = 0; n < 2; ++n) acc[a][b][m][n] = (f32x4){0.f, 0.f, 0.f, 0.f};
        cur = nxt; cA = nA; cB0 = nB0; cB1 = nB1; ++ui;
        if constexpr (Epi::PRE) { if (wid == 0) E.prefetch(cur, auxb + (ui & 1) * 1024, lane_now()); }
    }
    G8_WAIT_V(0);
    if (wr == 0) G8_BAR;
    G8_BAR;
#undef G8_SA
#undef G8_SB
#undef G8_STAGE2
#undef G8_STAGE_A
#undef G8_LDA
#undef G8_LDB
#undef G8_MMA
#undef G8_WAIT_V
#undef G8_WAIT_L
#undef G8_BAR
#undef G8_SCHED
}
}

__device__ __forceinline__ void tc_item(const float* W, int N, int Nvalid, bf16_t* WT, int k0, int n0, LAS float* scr, int lane) {
    const bool ok = (n0 + lane) < Nvalid;
    const float* src = W + (size_t)k0 * N + n0 + lane;
#pragma unroll 16
    for (int i = 0; i < 64; ++i) { const float v = ok ? src[(size_t)i * N] : 0.f; scr[i * 65 + lane] = v; }
    LDS_WAIT();
    const int c = lane & 7, nr = lane >> 3;
#pragma unroll
    for (int j = 0; j < 8; ++j) { const int n = nr + 8 * j; const LAS float* s = scr + (8 * c) * 65 + n;
        u32x4 o; o.x = cvt_pk_bf16(s[0], s[65]); o.y = cvt_pk_bf16(s[2 * 65], s[3 * 65]); o.z = cvt_pk_bf16(s[4 * 65], s[5 * 65]); o.w = cvt_pk_bf16(s[6 * 65], s[7 * 65]);
        *(u32x4*)(WT + (size_t)(n0 + n) * 1024 + k0 + 8 * c) = o; }
    LDS_WAIT();
}
struct ConvTile { const float* src; unsigned char* dst; int N; };
__device__ __forceinline__ void conv_load(const ConvTile& T, f32x4 (&r)[16], int lane) {
    const int kq = lane >> 4, nq = lane & 15;
    const float* p = T.src + (size_t)kq * T.N + nq * 4;
#pragma unroll
    for (int i = 0; i < 16; ++i) r[i] = __builtin_nontemporal_load((const f32x4*)(p + (size_t)(4 * i) * T.N));
}
__device__ __forceinline__ void conv_emit(const ConvTile& T, const f32x4 (&r)[16], LAS float* scr, int lane) {
    const int kq = lane >> 4, nq = lane & 15;
#pragma unroll
    for (int i = 0; i < 16; ++i) { LAS float* w = scr + (4 * i + kq) * 65 + nq * 4; w[0] = r[i].x; w[1] = r[i].y; w[2] = r[i].z; w[3] = r[i].w; }
    LDS_WAIT();
    const int c = lane & 7, nr = lane >> 3;
#pragma unroll
    for (int j = 0; j < 8; ++j) { const int n = nr + 8 * j; const LAS float* s = scr + (8 * c) * 65 + n;
        u32x2 o; o.x = pk4_fp8(s[0], s[65], s[2 * 65], s[3 * 65], Q8_W); o.y = pk4_fp8(s[4 * 65], s[5 * 65], s[6 * 65], s[7 * 65], Q8_W);
        __builtin_nontemporal_store(o, (u32x2*)(T.dst + (size_t)n * 1024 + 8 * c)); }
    LDS_WAIT();
}
__device__ __forceinline__ bool moe_conv_tile(const Frame& F, int l0, int it, int nitems, ConvTile& T) {
    if (it >= nitems) return false;
    const int l = l0 + it / 24576, r = it % 24576;
    if (r < 16384) { const int mi = l * 32 + (r >> 9), j = r & 511, kb = j >> 5, nb = j & 31;
        T.src = INP(F, I_WGU) + (size_t)mi * 1024 * 2048 + (size_t)(kb * 64) * 2048 + nb * 64; T.dst = WSP(F) + WS_WGU + (size_t)mi * 2048 * 1024 + (size_t)(nb * 64) * 1024 + kb * 64; T.N = 2048; }
    else { const int q = r - 16384, mi = l * 32 + (q >> 8), j = q & 255, kb = j >> 4, nb = j & 15;
        T.src = INP(F, I_WD) + (size_t)mi * 1024 * 1024 + (size_t)(kb * 64) * 1024 + nb * 64; T.dst = WSP(F) + WS_WD + (size_t)mi * 1024 * 1024 + (size_t)(nb * 64) * 1024 + kb * 64; T.N = 1024; }
    return true;
}
__device__ __forceinline__ void moe_convert(const Frame& F, int l0, int l1, int w, int nw) {
    LAS float* scr = (LAS float*)(F.lds + F.wave * 16640);
    const int nitems = (l1 - l0) * 24576;
    ConvTile Ta, Tb; f32x4 ra[16], rb[16];
    int it = w;
    bool va = moe_conv_tile(F, l0, it, nitems, Ta);
    if (va) conv_load(Ta, ra, F.lane);
    while (va) {
        const bool vb = moe_conv_tile(F, l0, it + nw, nitems, Tb);
        if (vb) conv_load(Tb, rb, F.lane);
        conv_emit(Ta, ra, scr, F.lane);
        if (!vb) break;
        it += 2 * nw;
        va = moe_conv_tile(F, l0, it, nitems, Ta);
        if (va) conv_load(Ta, ra, F.lane);
        conv_emit(Tb, rb, scr, F.lane);
    }
}
__device__ __forceinline__ void phase_p0(const Frame& F0) {
    Frame F = refresh(F0);
    {
        LAS float* cond = (LAS float*)F.lds; LAS float* red = cond + 5 * 1024;
        for (int i = F.tid; i < 5 * 1024; i += 512) { const int r = i >> 10, k = i & 1023; const float c = r < 4 ? INP(F, I_C)[r * 1024 + k] : INP(F, I_CCTX)[k]; cond[i] = c / (1.f + __expf(-c)); }
        __syncthreads();
        float* modv = (float*)(WSP(F) + WS_MODV);
        for (int it = F.bid; it < 384; it += F.G) {
            const int l = it / 96, n0 = (it % 96) * 64, k0 = F.wave * 128;
            const float* W = INP(F, I_MODW) + (size_t)l * 1024 * 6144 + (size_t)k0 * 6144 + n0 + F.lane;
            float a0 = 0.f, a1 = 0.f, a2 = 0.f, a3 = 0.f, a4 = 0.f;
#pragma unroll 8
            for (int k = 0; k < 128; ++k) { const float w = W[(size_t)k * 6144]; const LAS float* cp = cond + k0 + k;
                a0 += cp[0] * w; a1 += cp[1024] * w; a2 += cp[2048] * w; a3 += cp[3072] * w; a4 += cp[4096] * w; }
            LAS float* rp = red + F.wave * 320 + F.lane;
            rp[0] = a0; rp[64] = a1; rp[128] = a2; rp[192] = a3; rp[256] = a4;
            __syncthreads();
            if (F.tid < 320) { const int r = F.tid >> 6, ln = F.tid & 63; float s = 0.f;
#pragma unroll
                for (int w = 0; w < 8; ++w) s += red[w * 320 + r * 64 + ln];
                modv[(size_t)(l * 5 + r) * 6144 + n0 + ln] = s + INP(F, I_MODB)[l * 6144 + n0 + ln]; }
            __syncthreads();
        }
        __syncthreads();
    }
    {
        float* rw = (float*)(WSP(F) + WS_ROUTW);
        for (int idx = F.bid * 512 + F.tid; idx < 4 * 32 * 1024; idx += F.G * 512) { const int l = idx >> 15, rem = idx & 32767, k = rem >> 5, e = rem & 31;
            rw[(size_t)(l * 32 + e) * 1024 + k] = INP(F, I_RW)[idx]; }
    }
    {
        LAS float* scr = (LAS float*)(F.lds + F.wave * 16640);
        const int gw = F.bid * 8 + F.wave, NGW = F.G * 8;
        constexpr int I_A = 16 * 52, I_B = 16 * 32, I_O = 16 * 16, I_GU = 16 * 32, I_DN = 16 * 16;
        constexpr int E0 = I_A, E1 = 2 * I_A, E2 = E1 + I_B, E3 = E2 + I_A, E4 = E3 + 4 * I_O, E5 = E4 + 128 * I_GU, E6 = E5 + 128 * I_DN;
        bf16_t* win = (bf16_t*)(WSP(F) + WS_WIN);
        for (int it = gw; it < E4; it += NGW) {
            const float* W; bf16_t* WT; int N, Nv, nbn, j;
            if (it < E1) { const int q = it >= E0; j = it - q * I_A; W = INP(F, I_MWIN) + (size_t)q * 1024 * 3104; WT = win + (size_t)(q ? 3 : 0) * (7 * MiB / 2); N = 3104; Nv = 3104; nbn = 52; }
            else if (it < E2) { j = it - E1; W = INP(F, I_AWIN); WT = win + (size_t)1 * (7 * MiB / 2); N = 2048; Nv = 2048; nbn = 32; }
            else if (it < E3) { j = it - E2; W = INP(F, I_GWIN); WT = win + (size_t)2 * (7 * MiB / 2); N = 3104; Nv = 3104; nbn = 52; }
            else if (it < E4) { const int q = (it - E3) >> 8; j = (it - E3) & 255; N = 1024; Nv = 1024; nbn = 16;
                W = q == 0 ? INP(F, I_MWOUT) : q == 1 ? INP(F, I_AWOUT) : q == 2 ? INP(F, I_GWOUT) : INP(F, I_MWOUT) + (size_t)1024 * 1024;
                WT = (bf16_t*)(WSP(F) + WS_WOUT) + (size_t)q * 1024 * 1024; }
            else if (it < E5) { const int mi = (it - E4) >> 9; j = (it - E4) & 511; N = 2048; Nv = 2048; nbn = 32;
                W = INP(F, I_WGU) + (size_t)mi * 1024 * 2048; WT = (bf16_t*)(WSP(F) + WS_WGU) + (size_t)mi * 2048 * 1024; }
            else { const int mi = (it - E5) >> 8; j = (it - E5) & 255; N = 1024; Nv = 1024; nbn = 16;
                W = INP(F, I_WD) + (size_t)mi * 1024 * 1024; WT = (bf16_t*)(WSP(F) + WS_WD) + (size_t)mi * 1024 * 1024; }
            const int kb = j / nbn, nb = j % nbn;
            tc_item(W, N, Nv, WT, kb * 64, nb * 64, scr, F.lane);
        }
    }
}

__device__ __forceinline__ void moe_tstart_table(const Frame& F0, int l) {
    Frame F = refresh(F0);
    LAS int* tab = (LAS int*)(F.lds + TAB_OFF);
    if (F.tid < 64) {
        const unsigned* cnt = (const unsigned*)(WSP(F) + WS_CTL) + CW_CNT + l * 32;
        const int e = F.lane & 31;
        const int c = (int)__hip_atomic_load(cnt + e, __ATOMIC_RELAXED, __HIP_MEMORY_SCOPE_AGENT);
        const int nt = (c + 255) >> 8;
        int inc = nt;
#pragma unroll
        for (int d = 1; d < 32; d <<= 1) { const int t_ = __builtin_amdgcn_ds_bpermute((((F.lane & 31) >= d ? F.lane - d : F.lane)) << 2, inc); if ((F.lane & 31) >= d) inc += t_; }
        const int start = inc - nt;
        if (F.lane < 32) { tab[e] = c; tab[32 + e] = start; if (e == 31) tab[64] = inc;
#pragma nounroll
            for (int t = 0; t < nt; ++t) tab[80 + start + t] = e; }
    }
    __syncthreads();
}
__device__ __forceinline__ void phase_a(const Frame& F0, int l) {
    Frame F = refresh(F0);
    const LAS int* tab = (const LAS int*)(F.lds + TAB_OFF);
    if (l > 0) moe_tstart_table(F, l - 1);
    const int gw = F.bid * 8 + F.wave, NGW = F.G * 8;
    const float* modv = (const float*)(WSP(F) + WS_MODV);
    const bf16_t* Y2 = (const bf16_t*)(WSP(F) + WS_Y2);
    const int2* tokrec = (const int2*)(WSP(F) + WS_TOKREC);
    float* hctx = (float*)(WSP(F) + WS_HCTX);
    bf16_t* U = (bf16_t*)(WSP(F) + WS_U);
    constexpr int NR = 2;
    for (int row0 = (l == 4 ? NCTXR : 0) + gw; row0 < NTOK; row0 += NR * NGW) {
        int row[NR]; bool ok[NR]; int rr[NR]; float* hp[NR]; f32x4 v[NR][4]; int2 rc[NR][4];
#pragma unroll
        for (int q = 0; q < NR; ++q) { row[q] = row0 + q * NGW; ok[q] = row[q] < NTOK; if (!ok[q]) row[q] = row0;
            const bool isctx = row[q] < NCTXR; rr[q] = isctx ? 4 : ((row[q] - NCTXR) >> 12);
            hp[q] = isctx ? hctx + (size_t)row[q] * DM : OUTP(F) + (size_t)(row[q] - NCTXR) * DM;
            const float* src = (l == 0) ? (isctx ? INP(F, I_CTX) + (size_t)row[q] * DM : INP(F, I_X) + (size_t)(row[q] - NCTXR) * DM) : hp[q];
#pragma unroll
            for (int j = 0; j < 4; ++j) v[q][j] = *((const f32x4*)src + F.lane + 64 * j);
            if (l > 0) {
#pragma unroll
                for (int k = 0; k < 4; ++k) rc[q][k] = tokrec[row[q] * 4 + k]; } }
        if (l > 0) {
            u32x2 yw[NR][4][4], dw[NR][4];
            const bf16_t* DELTA = (const bf16_t*)(WSP(F) + WS_DELTA);
#pragma unroll
            for (int q = 0; q < NR; ++q)
#pragma unroll
                for (int j = 0; j < 4; ++j) dw[q][j] = *((const u32x2*)(DELTA + (size_t)row[q] * DM) + F.lane + 64 * j);
#pragma unroll
            for (int q = 0; q < NR; ++q)
#pragma unroll
                for (int k = 0; k < 4; ++k) { const int e = rc[q][k].x >> 15, pos = rc[q][k].x & 32767;
                    const bf16_t* yp = Y2 + (size_t)(tab[32 + e] * 256 + pos) * DM;
#pragma unroll
                    for (int j = 0; j < 4; ++j) yw[q][k][j] = *((const u32x2*)yp + F.lane + 64 * j); }
#pragma unroll
            for (int q = 0; q < NR; ++q) {
                const float* m5 = modv + (size_t)((l - 1) * 5 + rr[q]) * 6144 + 5 * 1024;
#pragma unroll
                for (int j = 0; j < 4; ++j) { f32x4 acc = (f32x4){0.f, 0.f, 0.f, 0.f};
#pragma unroll
                    for (int k = 0; k < 4; ++k) { const u32x2 w = yw[q][k][j]; acc += __int_as_float(rc[q][k].y) * (f32x4){bflo(w.x), bfhi(w.x), bflo(w.y), bfhi(w.y)}; }
                    v[q][j] += (f32x4){bflo(dw[q][j].x), bfhi(dw[q][j].x), bflo(dw[q][j].y), bfhi(dw[q][j].y)} + *((const f32x4*)m5 + F.lane + 64 * j) * acc; } }
        }
#pragma unroll
        for (int q = 0; q < NR; ++q) {
            if (!ok[q]) continue;
#pragma unroll
            for (int j = 0; j < 4; ++j) *((f32x4*)hp[q] + F.lane + 64 * j) = v[q][j];
        }
        if (l < 4) {
            float ss[NR];
#pragma unroll
            for (int q = 0; q < NR; ++q) { ss[q] = 0.f;
#pragma unroll
                for (int j = 0; j < 4; ++j) ss[q] += (v[q][j].x * v[q][j].x + v[q][j].y * v[q][j].y) + (v[q][j].z * v[q][j].z + v[q][j].w * v[q][j].w); }
#pragma unroll
        for (int q = 0; q < NR; ++q) ss[q] = wave_sum(ss[q], F.lane);
            const float* g1 = INP(F, I_N1G) + l * DM;
#pragma unroll
            for (int q = 0; q < NR; ++q) {
                if (!ok[q]) continue;
                const float rstd = rsqrtf(ss[q] * (1.f / DM) + NORM_EPS);
                const float* m0 = modv + (size_t)(l * 5 + rr[q]) * 6144; const float* m1 = m0 + 1024;
#pragma unroll
                for (int j = 0; j < 4; ++j) { const f32x4 g = *((const f32x4*)g1 + F.lane + 64 * j), sh = *((const f32x4*)m0 + F.lane + 64 * j), sc = *((const f32x4*)m1 + F.lane + 64 * j);
                    const f32x4 u = v[q][j] * rstd * g * (sc + 1.f) + sh;
                    u32x2 w; w.x = cvt_pk_bf16(u.x, u.y); w.y = cvt_pk_bf16(u.z, u.w);
                    *((u32x2*)(U + (size_t)row[q] * DM) + F.lane + 64 * j) = w; }
            }
        }
    }
}

__device__ __forceinline__ void route_row(float (&p)[8], float rb, int lane, bool ok, int lr, LAS float* lg) {
    const int hi16 = (lane >> 4) & 1, hi8 = (lane >> 3) & 1, hi4 = (lane >> 2) & 1;
#pragma unroll
    for (int i = 0; i < 4; ++i) { const float send = hi16 ? p[i] : p[i + 4], keep = hi16 ? p[i + 4] : p[i]; p[i] = keep + xch<16>(send, lane); }
#pragma unroll
    for (int i = 0; i < 2; ++i) { const float send = hi8 ? p[i] : p[i + 2], keep = hi8 ? p[i + 2] : p[i]; p[i] = keep + xch<8>(send, lane); }
    { const float send = hi4 ? p[0] : p[1], keep = hi4 ? p[1] : p[0]; p[0] = keep + xch<4>(send, lane); }
    const float val = p[0] + xch<32>(p[0], lane) + rb;
    if (lane < 32 && ok) lg[lr * 33 + lane] = val;
}
__device__ __forceinline__ void phase_e(const Frame& F0, int l) {
    Frame F = refresh(F0);
    LAS f32x4* wr4 = (LAS f32x4*)F.lds;
    LAS int* cntl = (LAS int*)(F.lds + TAB_OFF);
    LAS int* basel = cntl + 32;
    LAS int* recs = cntl + 64;
    LAS float* lg = (LAS float*)(recs + 272 * 4);
    static_assert(TAB_OFF + 256 + 272 * 16 + 68 * 33 * 4 <= MISC_OFF, "phase E LDS map");
    const bool lastl = (l == DEPTH - 1);
    { const f32x4* src = (const f32x4*)((const float*)(WSP(F) + WS_ROUTW) + (size_t)l * 32 * 1024);
      for (int i = F.tid; i < 8192; i += 512) wr4[i] = src[i];
      if (F.tid < 32) cntl[F.tid] = 0; }
    __syncthreads();
    const float* modv = (const float*)(WSP(F) + WS_MODV);
    const float* hctx = (const float*)(WSP(F) + WS_HCTX);
    unsigned char* U8 = WSP(F) + WS_U;
    constexpr int RPB = NTOK / 256;
    const float rb = INP(F, I_RB)[l * 32 + (F.lane & 31)];
    const float* g2 = INP(F, I_N2G) + l * DM;
    const bf16_t* DELTA = (const bf16_t*)(WSP(F) + WS_DELTA);
#pragma nounroll
    for (int lr0 = F.wave; lr0 < RPB; lr0 += 8 * 3) {
        constexpr int NR = 3;
        int lrq[NR], row[NR]; bool ok[NR]; f32x4 v[NR][4]; float ss[NR];
#pragma unroll
        for (int q = 0; q < NR; ++q) { lrq[q] = lr0 + 8 * q; ok[q] = lrq[q] < RPB; if (!ok[q]) lrq[q] = lr0; row[q] = F.bid * RPB + lrq[q];
            const bool isctx = row[q] < NCTXR;
            const float* hp = isctx ? hctx + (size_t)row[q] * DM : OUTP(F) + (size_t)(row[q] - NCTXR) * DM;
            ss[q] = 0.f;
#pragma unroll
            for (int j = 0; j < 4; ++j) { const u32x2 dw = *((const u32x2*)(DELTA + (size_t)row[q] * DM) + F.lane + 64 * j);
                v[q][j] = *((const f32x4*)hp + F.lane + 64 * j) + (f32x4){bflo(dw.x), bfhi(dw.x), bflo(dw.y), bfhi(dw.y)}; ss[q] += (v[q][j].x * v[q][j].x + v[q][j].y * v[q][j].y) + (v[q][j].z * v[q][j].z + v[q][j].w * v[q][j].w); } }
#pragma unroll
        for (int q = 0; q < NR; ++q) ss[q] = wave_sum(ss[q], F.lane);
#pragma unroll
        for (int q = 0; q < NR; ++q) {
            const int r = row[q] < NCTXR ? 4 : ((row[q] - NCTXR) >> 12);
            const float rstd = rsqrtf(ss[q] * (1.f / DM) + NORM_EPS);
            const float* m3 = modv + (size_t)(l * 5 + r) * 6144 + 3 * 1024; const float* m4 = m3 + 1024;
#pragma unroll
            for (int j = 0; j < 4; ++j) { const f32x4 g = *((const f32x4*)g2 + F.lane + 64 * j), sh = *((const f32x4*)m3 + F.lane + 64 * j), sc = *((const f32x4*)m4 + F.lane + 64 * j);
                v[q][j] = v[q][j] * rstd * g * (sc + 1.f) + sh;
                if (ok[q]) *((unsigned*)(U8 + (size_t)row[q] * DM) + F.lane + 64 * j) = pk4_fp8(v[q][j].x, v[q][j].y, v[q][j].z, v[q][j].w, Q8_U); } }
        float pg[NR][8];
        int woff = F.lane; asm volatile("" : "+v"(woff));
        const int hb1 = F.lane & 1, hb2 = (F.lane >> 1) & 1;
#pragma unroll
        for (int g = 0; g < 8; ++g) {
            float sg[NR][4];
#pragma unroll
            for (int i = 0; i < 4; ++i) { f32x2 a2[NR];
#pragma unroll
                for (int q = 0; q < NR; ++q) a2[q] = (f32x2){0.f, 0.f};
#pragma unroll
                for (int j = 0; j < 4; ++j) { const f32x4 w = wr4[(4 * g + i) * 256 + j * 64 + woff];
                    const f32x2 wl = (f32x2){w.x, w.y}, wh = (f32x2){w.z, w.w};
#pragma unroll
                    for (int q = 0; q < NR; ++q) { a2[q] = __builtin_elementwise_fma((f32x2){v[q][j].x, v[q][j].y}, wl, a2[q]); a2[q] = __builtin_elementwise_fma((f32x2){v[q][j].z, v[q][j].w}, wh, a2[q]); } }
#pragma unroll
                for (int q = 0; q < NR; ++q) sg[q][i] = a2[q].x + a2[q].y; }
#pragma unroll
            for (int q = 0; q < NR; ++q) {
                const float t0 = (hb1 ? sg[q][1] : sg[q][0]) + xch<1>(hb1 ? sg[q][0] : sg[q][1], F.lane);
                const float t1 = (hb1 ? sg[q][3] : sg[q][2]) + xch<1>(hb1 ? sg[q][2] : sg[q][3], F.lane);
                pg[q][g] = (hb2 ? t1 : t0) + xch<2>(hb2 ? t0 : t1, F.lane); }
        }
#pragma unroll
        for (int q = 0; q < NR; ++q) route_row(pg[q], rb, F.lane, ok[q], lrq[q], lg);
    }
    __syncthreads();
    int nrec = 0;
    if (F.tid < RPB) {
        const int lr = F.tid, row = F.bid * RPB + lr;
        if (!(lastl && row < NCTXR)) {
            float v0 = -3.0e38f, v1 = -3.0e38f, v2 = -3.0e38f, v3 = -3.0e38f; int i0 = 0, i1 = 0, i2 = 0, i3 = 0;
            for (int e = 0; e < 32; ++e) { float t = lg[lr * 33 + e]; int ti = e;
                if (t > v0) { const float a = v0; v0 = t; t = a; const int b = i0; i0 = ti; ti = b; }
                if (t > v1) { const float a = v1; v1 = t; t = a; const int b = i1; i1 = ti; ti = b; }
                if (t > v2) { const float a = v2; v2 = t; t = a; const int b = i2; i2 = ti; ti = b; }
                if (t > v3) { v3 = t; i3 = ti; } }
            const float e1 = __expf(v1 - v0), e2 = __expf(v2 - v0), e3 = __expf(v3 - v0);
            const float inv = 1.f / (1.f + e1 + e2 + e3);
            const float gk[4] = {inv, e1 * inv, e2 * inv, e3 * inv}; const int te[4] = {i0, i1, i2, i3};
#pragma unroll
            for (int k = 0; k < 4; ++k) { const int lp = atomicAdd((int*)(cntl + te[k]), 1); LAS int* rp = recs + (lr * 4 + k) * 4; rp[0] = row; rp[1] = te[k]; rp[2] = lp; rp[3] = __float_as_int(gk[k]); }
            nrec = 1;
        } else { recs[(lr * 4) * 4] = -1; recs[(lr * 4 + 1) * 4] = -1; recs[(lr * 4 + 2) * 4] = -1; recs[(lr * 4 + 3) * 4] = -1; }
    }
    (void)nrec;
    __syncthreads();
    if (F.tid < 32) { unsigned* cnt = (unsigned*)(WSP(F) + WS_CTL) + CW_CNT + l * 32; basel[F.tid] = (int)atomicAdd(cnt + F.tid, (unsigned)cntl[F.tid]); }
    __syncthreads();
    int* slottok = (int*)(WSP(F) + WS_SLOTTOK); int2* tokrec = (int2*)(WSP(F) + WS_TOKREC);
    for (int i = F.tid; i < RPB * 4; i += 512) { const LAS int* rp = recs + i * 4; const int row = rp[0]; if (row < 0) continue; const int e = rp[1], pos = basel[e] + rp[2];
        slottok[e * NTOK + pos] = row; tokrec[row * 4 + (i & 3)] = make_int2((e << 15) | pos, rp[3]); }
    __syncthreads();
}

__device__ __forceinline__ bf16x8 lds_frag(const LAS bf16_t* base, int ld, int row0, int k0, int fr, int fq) {
    return *(const LAS bf16x8*)(base + (row0 + fr) * ld + k0 + fq * 8);
}
#define MMA16(a, b, c) __builtin_amdgcn_mfma_f32_16x16x32_bf16(a, b, c, 0, 0, 0)

__device__ __forceinline__ int scan_row(int b, int dir, int p) {
    if (p < CTXL) return b * CTXL + (dir ? CTXL - 1 - p : p);
    const int pl = p - CTXL; return NCTXR + b * SEQ + (dir ? SEQ - 1 - pl : pl);
}
__device__ __forceinline__ void tri_tile(int id, int& ti, int& si) { ti = id >= 6 ? 3 : id >= 3 ? 2 : id >= 1 ? 1 : 0; si = id - (ti * (ti + 1)) / 2; }

__device__ __forceinline__ void phase_c1a(const Frame& F0, int jl) {
    Frame F = refresh(F0);
    const int gw = F.bid * 8 + F.wave, NGW = F.G * 8;
    const bf16_t* P = (const bf16_t*)(WSP(F) + WS_P);
    bf16_t* QK = (bf16_t*)(WSP(F) + WS_AUX + AUX_QK);
    const float* cw = INP(F, I_MCONV) + (size_t)jl * 3 * 1024;
    f32x4 w0[4], w1[4], w2[4];
#pragma unroll
    for (int j = 0; j < 4; ++j) { w0[j] = *((const f32x4*)cw + F.lane + 64 * j); w1[j] = *((const f32x4*)(cw + 1024) + F.lane + 64 * j); w2[j] = *((const f32x4*)(cw + 2048) + F.lane + 64 * j); }
    for (int row = gw; row < NTOK; row += NGW) {
        const bool isctx = row < NCTXR; const int t = isctx ? (row & (CTXL - 1)) : ((row - NCTXR) & (SEQ - 1)); const int tl = isctx ? CTXL - 1 : SEQ - 1;
        const bool hp = t > 0, hn = t < tl;
        const bf16_t* pr = P + (size_t)row * NPAD_A;
#pragma unroll
        for (int j = 0; j < 4; ++j) {
            const u32x2 c0 = *((const u32x2*)pr + F.lane + 64 * j);
            u32x2 cm = (u32x2){0u, 0u}, cp = (u32x2){0u, 0u};
            if (hp) cm = *((const u32x2*)(pr - NPAD_A) + F.lane + 64 * j);
            if (hn) cp = *((const u32x2*)(pr + NPAD_A) + F.lane + 64 * j);
            f32x4 x = w0[j] * (f32x4){bflo(cm.x), bfhi(cm.x), bflo(cm.y), bfhi(cm.y)} + w1[j] * (f32x4){bflo(c0.x), bfhi(c0.x), bflo(c0.y), bfhi(c0.y)}
                    + w2[j] * (f32x4){bflo(cp.x), bfhi(cp.x), bflo(cp.y), bfhi(cp.y)};
            const float sc = (j < 2) ? 0.125f : 1.f;
            x.x = sc * x.x / (1.f + __expf(-x.x)); x.y = sc * x.y / (1.f + __expf(-x.y)); x.z = sc * x.z / (1.f + __expf(-x.z)); x.w = sc * x.w / (1.f + __expf(-x.w));
            u32x2 w; w.x = cvt_pk_bf16(x.x, x.y); w.y = cvt_pk_bf16(x.z, x.w);
            *((u32x2*)(QK + (size_t)row * DM) + F.lane + 64 * j) = w;
        }
    }
    const float* gb = INP(F, I_MGB) + jl * 32;
    f32x4* G = (f32x4*)(WSP(F) + WS_GATES);
    for (int ch = gw; ch < NTOK / 64; ch += NGW) {
        const int row = ch * 64 + F.lane;
        const u32x4* gp = (const u32x4*)(P + (size_t)row * NPAD_A + 3072);
        unsigned gwd[16];
#pragma unroll
        for (int q = 0; q < 4; ++q) { const u32x4 w = gp[q]; gwd[q * 4] = w.x; gwd[q * 4 + 1] = w.y; gwd[q * 4 + 2] = w.z; gwd[q * 4 + 3] = w.w; }
#pragma unroll
        for (int h = 0; h < 8; ++h) {
            const float i_f = ((h & 1) ? bfhi(gwd[(0 + h) >> 1]) : bflo(gwd[(0 + h) >> 1])) + gb[h];
            const float f_f = ((h & 1) ? bfhi(gwd[(8 + h) >> 1]) : bflo(gwd[(8 + h) >> 1])) + gb[8 + h];
            const float i_b = ((h & 1) ? bfhi(gwd[(16 + h) >> 1]) : bflo(gwd[(16 + h) >> 1])) + gb[16 + h];
            const float f_b = ((h & 1) ? bfhi(gwd[(24 + h) >> 1]) : bflo(gwd[(24 + h) >> 1])) + gb[24 + h];
            float bf_ = logsigmoidf_(f_f), bb_ = logsigmoidf_(f_b);
#pragma unroll
            for (int d = 1; d < 64; d <<= 1) { const float tf = shup(bf_, d, F.lane), tb = shdn(bb_, d, F.lane); if (F.lane >= d) bf_ += tf; if (F.lane + d < 64) bb_ += tb; }
            const float af = i_f - bf_, ab_ = i_b - bb_;
            float pf = af, pb = ab_;
#pragma unroll
            for (int d = 1; d < 64; d <<= 1) { const float tf = shup(pf, d, F.lane), tb = shdn(pb, d, F.lane); if (F.lane >= d) pf = fmaxf(pf, tf); if (F.lane + d < 64) pb = fmaxf(pb, tb); }
            G[(size_t)row * 16 + h] = (f32x4){af, bf_, pf, 0.f};
            G[(size_t)row * 16 + 8 + h] = (f32x4){ab_, bb_, pb, 0.f};
        }
    }
}

__device__ __forceinline__ unsigned off_b(unsigned row, unsigned ch) { return 256u * row + 16u * (ch ^ (((row & 3u) << 2) | ((row >> 2) & 3u))); }
__device__ __forceinline__ unsigned tr_addr16(unsigned lane, unsigned c, unsigned ks, unsigned t) {
    const unsigned g = lane >> 4, q = (lane & 15u) >> 2, p = lane & 3u;
    return off_b(32u * ks + 8u * g + 4u * t + q, 2u * c + (p >> 1)) + 8u * (p & 1u);
}
typedef short s16x4 __attribute__((ext_vector_type(4)));
__device__ __forceinline__ s16x4 tr_read(unsigned addr) { s16x4 r; asm volatile("ds_read_b64_tr_b16 %0, %1" : "=&v"(r) : "v"(addr) : "memory"); return r; }
#define TR_WAIT2(a, b) asm volatile("s_waitcnt lgkmcnt(0)" : "+v"(a), "+v"(b) :: "memory")
__device__ __forceinline__ bf16x8 cat4(s16x4 lo, s16x4 hi) { return (bf16x8){lo[0], lo[1], lo[2], lo[3], hi[0], hi[1], hi[2], hi[3]}; }

__device__ __forceinline__ void phase_c2a(const Frame& F0, bool last_layer, int cl0, int cl1) {
    Frame F = refresh(F0);
    if (F.bid >= 64) { if (cl1 > cl0) moe_convert(F, cl0, cl1, (F.bid - 64) * 8 + F.wave, (F.G - 64) * 8); return; }
    const int b = F.bid >> 4, h = (F.bid >> 1) & 7, dir = F.bid & 1;
    constexpr int LD = 72, NCH = (CTXL + SEQ) / 64, LH = 136;
    constexpr int O_KS = 2 * 64 * LD * 2, O_KW = O_KS / 2 * 2 + 0, IN_BYTES = 2 * 64 * LD * 2 + 8192 + 16384 + 1024;
    constexpr int OFF_KW = 2 * 64 * LD * 2, OFF_V = OFF_KW + 8192, OFF_AB = OFF_V + 16384;
    LAS unsigned char* L0 = F.lds;
    LAS bf16_t* Sb = (LAS bf16_t*)(L0 + 2 * IN_BYTES); LAS bf16_t* Hs = Sb + 64 * LD;
    LAS float* MT = (LAS float*)(Hs + 64 * LH);
    LAS float* rdn_s = MT + 4 * NCH;
    constexpr int LDS_USED = 2 * IN_BYTES + 64 * LD * 2 + 64 * LH * 2 + 4 * NCH * 4 + 256;
    static_assert(LDS_USED <= MISC_OFF && (O_KS | O_KW) >= 0, "C2a LDS map");
    { LAS unsigned* z = (LAS unsigned*)L0; for (int i = F.tid; i < LDS_USED / 4; i += 512) z[i] = 0u; }
    const bf16_t* QK = (const bf16_t*)(WSP(F) + WS_AUX + AUX_QK);
    const bf16_t* P = (const bf16_t*)(WSP(F) + WS_P);
    const f32x4* G = (const f32x4*)(WSP(F) + WS_GATES);
    bf16_t* HD = (bf16_t*)(WSP(F) + WS_HDIR) + (size_t)dir * NTOK * DM;
    __syncthreads();
    if (F.tid < NCH) { const f32x4 g = G[(size_t)scan_row(b, dir, F.tid * 64 + 63) * 16 + dir * 8 + h]; MT[2 * NCH + F.tid] = g.y; MT[3 * NCH + F.tid] = g.z; }
    __syncthreads();
    if (F.tid == 0) { float m = 0.f;
        for (int c = 0; c < NCH; ++c) { const float cm63 = fmaxf(m, MT[3 * NCH + c]); MT[c] = m; MT[NCH + c] = cm63; m = MT[2 * NCH + c] + cm63; } }
    __syncthreads();
    const int fr = F.lane & 15, fq = F.lane >> 4;
    const int qr = F.tid >> 3, qc = F.tid & 7;
    u32x4 rq, rk, rv0, rv1; float ra = 0.f; f32x4 rab = (f32x4){0.f, 0.f, 0.f, 0.f};
#define C2A_LOAD(c) do { const int p0_ = (c) * 64; \
        const size_t rowq = (size_t)scan_row(b, dir, p0_ + qr); \
        rq = *(const u32x4*)(QK + rowq * DM + h * 64 + qc * 8); rk = *(const u32x4*)(QK + rowq * DM + 512 + h * 64 + qc * 8); \
        ra = ((const float*)(G + rowq * 16 + dir * 8 + h))[0]; \
        rv0 = *(const u32x4*)(P + (size_t)scan_row(b, dir, p0_ + (F.tid >> 4)) * NPAD_A + 1024 + h * 128 + (F.tid & 15) * 8); \
        rv1 = *(const u32x4*)(P + (size_t)scan_row(b, dir, p0_ + 32 + (F.tid >> 4)) * NPAD_A + 1024 + h * 128 + (F.tid & 15) * 8); \
        if (F.tid < 64) rab = G[(size_t)scan_row(b, dir, p0_ + F.tid) * 16 + dir * 8 + h]; } while (0)
#define C2A_STAGE(c, buf) do { LAS unsigned char* B_ = L0 + (buf) * IN_BYTES; \
        *(LAS u32x4*)(B_ + (qr * LD + qc * 8) * 2) = rq; *(LAS u32x4*)(B_ + 64 * LD * 2 + (qr * LD + qc * 8) * 2) = rk; \
        { const float wg_ = __expf(ra - MT[NCH + (c)]); u32x4 kw_; \
          kw_.x = cvt_pk_bf16(bflo(rk.x) * wg_, bfhi(rk.x) * wg_); kw_.y = cvt_pk_bf16(bflo(rk.y) * wg_, bfhi(rk.y) * wg_); kw_.z = cvt_pk_bf16(bflo(rk.z) * wg_, bfhi(rk.z) * wg_); kw_.w = cvt_pk_bf16(bflo(rk.w) * wg_, bfhi(rk.w) * wg_); \
          *(LAS u32x4*)(B_ + OFF_KW + off_b(qr & 31, 8 * (qr >> 5) + qc)) = kw_; } \
        *(LAS u32x4*)(B_ + OFF_V + off_b(F.tid >> 4, F.tid & 15)) = rv0; *(LAS u32x4*)(B_ + OFF_V + off_b(32 + (F.tid >> 4), F.tid & 15)) = rv1; \
        if (F.tid < 64) { const float mc_ = MT[(c)], cm_ = fmaxf(mc_, rab.z); \
            ((LAS f32x4*)(B_ + OFF_AB))[F.tid] = (f32x4){rab.x, cm_, __expf(mc_ - cm_), __expf(-(rab.y + cm_))}; } } while (0)
    C2A_LOAD(0); C2A_STAGE(0, 0); C2A_LOAD(1);
    f32x4 CT[4], CN[4];
#pragma unroll
    for (int i = 0; i < 4; ++i) { CT[i] = (f32x4){0.f, 0.f, 0.f, 0.f}; CN[i] = (f32x4){0.f, 0.f, 0.f, 0.f}; }
    unsigned one2; asm volatile("v_mov_b32 %0, 0x3f803f80" : "=v"(one2));
    const bf16x8 ONES = __builtin_bit_cast(bf16x8, (u32x4){one2, one2, one2, one2});
    const unsigned lbase = (unsigned)(size_t)L0;
    for (int c = 0; c <= NCH; ++c) {
        __syncthreads();
        const int buf = c & 1;
        if (c + 1 < NCH) C2A_STAGE(c + 1, buf ^ 1);
        if (c > 0 && !(last_layer && c - 1 < CTXL / 64)) {
            const int row0 = scan_row(b, dir, (c - 1) * 64), rstep = dir ? -1 : 1;
#pragma unroll
            for (int i = 0; i < 2; ++i) { const int pc = F.tid + 512 * i, r_ = pc >> 4, ch_ = pc & 15;
                const u32x4 nw = *(const LAS u32x4*)(Hs + r_ * LH + ch_ * 8); const float rd_ = rdn_s[r_];
                u32x4 hw; hw.x = cvt_pk_bf16(bflo(nw.x) * rd_, bfhi(nw.x) * rd_); hw.y = cvt_pk_bf16(bflo(nw.y) * rd_, bfhi(nw.y) * rd_); hw.z = cvt_pk_bf16(bflo(nw.z) * rd_, bfhi(nw.z) * rd_); hw.w = cvt_pk_bf16(bflo(nw.w) * rd_, bfhi(nw.w) * rd_);
                *(u32x4*)(HD + (size_t)(row0 + rstep * r_) * DM + h * 128 + ch_ * 8) = hw; }
        }
        if (c == NCH) break;
        if (c + 2 < NCH) C2A_LOAD(c + 2);
        const LAS bf16_t* Qs = (const LAS bf16_t*)(L0 + buf * IN_BYTES); const LAS bf16_t* Ks = Qs + 64 * LD;
        const LAS f32x4* AB = (const LAS f32x4*)(L0 + buf * IN_BYTES + OFF_AB);
        const float mc = MT[c];
        for (int id = F.wave; id < 10; id += 8) {
            int ti, si; tri_tile(id, ti, si);
            f32x4 acc = (f32x4){0.f, 0.f, 0.f, 0.f};
#pragma unroll
            for (int kk = 0; kk < 2; ++kk) acc = MMA16(lds_frag(Qs, LD, ti * 16, kk * 32, fr, fq), lds_frag(Ks, LD, si * 16, kk * 32, fr, fq), acc);
            const int s_ = si * 16 + fr; const float as = AB[s_].x;
#pragma unroll
            for (int j = 0; j < 4; ++j) { const int t = ti * 16 + fq * 4 + j; const float w = (s_ <= t) ? __expf(as - AB[t].y) : 0.f; Sb[t * LD + s_] = f2bf(acc[j] * w); }
        }
        __syncthreads();
        const float decay = __expf(mc - MT[NCH + c]);
        const unsigned vbase = lbase + buf * IN_BYTES + OFF_V, kbase = lbase + buf * IN_BYTES + OFF_KW;
        s16x4 v00 = tr_read(vbase + tr_addr16(F.lane, F.wave, 0, 0)), v01 = tr_read(vbase + tr_addr16(F.lane, F.wave, 0, 1));
        s16x4 v10 = tr_read(vbase + tr_addr16(F.lane, F.wave, 1, 0)), v11 = tr_read(vbase + tr_addr16(F.lane, F.wave, 1, 1));
        TR_WAIT2(v00, v01); TR_WAIT2(v10, v11);
        const bf16x8 vf0 = cat4(v00, v01), vf1 = cat4(v10, v11);
        const bool denw = F.wave < 4;
        bf16x8 cb[2], nb[2];
#pragma unroll
        for (int kk = 0; kk < 2; ++kk) {
            u32x4 w; w.x = cvt_pk_bf16(CT[2 * kk][0], CT[2 * kk][1]); w.y = cvt_pk_bf16(CT[2 * kk][2], CT[2 * kk][3]); w.z = cvt_pk_bf16(CT[2 * kk + 1][0], CT[2 * kk + 1][1]); w.w = cvt_pk_bf16(CT[2 * kk + 1][2], CT[2 * kk + 1][3]);
            cb[kk] = __builtin_bit_cast(bf16x8, w);
            u32x4 x; x.x = cvt_pk_bf16(CN[2 * kk][0], CN[2 * kk][1]); x.y = cvt_pk_bf16(CN[2 * kk][2], CN[2 * kk][3]); x.z = cvt_pk_bf16(CN[2 * kk + 1][0], CN[2 * kk + 1][1]); x.w = cvt_pk_bf16(CN[2 * kk + 1][2], CN[2 * kk + 1][3]);
            nb[kk] = __builtin_bit_cast(bf16x8, x); }
#pragma unroll
        for (int ti = 0; ti < 4; ++ti) {
            f32x4 aC = (f32x4){0.f, 0.f, 0.f, 0.f}, aS = aC;
            bf16x8 qa[2];
#pragma unroll
            for (int kk = 0; kk < 2; ++kk) {
                const u32x2 qlo = *(const LAS u32x2*)(Qs + (ti * 16 + fr) * LD + kk * 32 + 4 * fq), qhi = *(const LAS u32x2*)(Qs + (ti * 16 + fr) * LD + kk * 32 + 16 + 4 * fq);
                const u32x4 qw = (u32x4){qlo.x, qlo.y, qhi.x, qhi.y}; qa[kk] = __builtin_bit_cast(bf16x8, qw);
                aC = MMA16(qa[kk], cb[kk], aC); }
            const bf16x8 sa0 = lds_frag(Sb, LD, ti * 16, 0, fr, fq); aS = MMA16(sa0, vf0, aS);
            bf16x8 sa1 = sa0; if (ti >= 2) { sa1 = lds_frag(Sb, LD, ti * 16, 32, fr, fq); aS = MMA16(sa1, vf1, aS); }
            f32x4 gg[4];
#pragma unroll
            for (int j = 0; j < 4; ++j) gg[j] = AB[ti * 16 + fq * 4 + j];
#pragma unroll
            for (int j = 0; j < 4; ++j) Hs[(ti * 16 + fq * 4 + j) * LH + F.wave * 16 + fr] = f2bf(gg[j].z * aC[j] + aS[j]);
            if (denw && F.wave == ti) {
                f32x4 aCn = (f32x4){0.f, 0.f, 0.f, 0.f}, aSn = aCn;
                aCn = MMA16(qa[0], nb[0], aCn); aCn = MMA16(qa[1], nb[1], aCn);
                aSn = MMA16(sa0, ONES, aSn); if (ti >= 2) aSn = MMA16(sa1, ONES, aSn);
                if (fr == 0) {
#pragma unroll
                    for (int j = 0; j < 4; ++j) rdn_s[ti * 16 + fq * 4 + j] = __builtin_amdgcn_rcpf(fmaxf(fabsf(gg[j].z * aCn[j] + aSn[j]), gg[j].w)); }
            }
        }
        s16x4 kq[4][4];
#pragma unroll
        for (int di = 0; di < 4; ++di) { kq[di][0] = tr_read(kbase + tr_addr16(F.lane, di, 0, 0)); kq[di][1] = tr_read(kbase + tr_addr16(F.lane, di, 0, 1));
            kq[di][2] = tr_read(kbase + tr_addr16(F.lane, 4 + di, 0, 0)); kq[di][3] = tr_read(kbase + tr_addr16(F.lane, 4 + di, 0, 1)); }
#pragma unroll
        for (int di = 0; di < 4; ++di) { TR_WAIT2(kq[di][0], kq[di][1]); TR_WAIT2(kq[di][2], kq[di][3]); }
#pragma unroll
        for (int di = 0; di < 4; ++di) {
            const bf16x8 kf0 = cat4(kq[di][0], kq[di][1]), kf1 = cat4(kq[di][2], kq[di][3]);
            f32x4 a = CT[di] * decay;
            a = MMA16(kf0, vf0, a); a = MMA16(kf1, vf1, a); CT[di] = a;
            if (denw) { f32x4 an = CN[di] * decay; an = MMA16(kf0, ONES, an); an = MMA16(kf1, ONES, an); CN[di] = an; }
        }
    }
#undef C2A_LOAD
#undef C2A_STAGE
}

__device__ __forceinline__ void phase_c3a(const Frame& F0, int jl) {
    Frame F = refresh(F0);
    const int gw = F.bid * 8 + F.wave, NGW = F.G * 8;
    const bf16_t* P = (const bf16_t*)(WSP(F) + WS_P);
    const bf16_t* H0 = (const bf16_t*)(WSP(F) + WS_HDIR); const bf16_t* H1 = H0 + (size_t)NTOK * DM;
    bf16_t* Y = (bf16_t*)(WSP(F) + WS_YPRE);
    const float* ng = INP(F, I_MNG) + (size_t)jl * DM;
    f32x4 g[4];
#pragma unroll
    for (int j = 0; j < 4; ++j) g[j] = *((const f32x4*)ng + F.lane + 64 * j);
    constexpr int NR = 4;
    for (int row0 = gw; row0 < NTOK; row0 += NR * NGW) {
        int row[NR]; bool ok[NR]; u32x2 a[NR][4], bq[NR][4], ov[NR][4];
#pragma unroll
        for (int q = 0; q < NR; ++q) { row[q] = row0 + q * NGW; ok[q] = row[q] < NTOK; if (!ok[q]) row[q] = row0;
#pragma unroll
            for (int j = 0; j < 4; ++j) {
                a[q][j] = *((const u32x2*)(H0 + (size_t)row[q] * DM) + F.lane + 64 * j); bq[q][j] = *((const u32x2*)(H1 + (size_t)row[q] * DM) + F.lane + 64 * j);
                ov[q][j] = *((const u32x2*)(P + (size_t)row[q] * NPAD_A + 2048) + F.lane + 64 * j); } }
        f32x4 x[NR][4]; float ss[NR][4];
#pragma unroll
        for (int q = 0; q < NR; ++q)
#pragma unroll
            for (int j = 0; j < 4; ++j) { x[q][j] = (f32x4){bflo(a[q][j].x) + bflo(bq[q][j].x), bfhi(a[q][j].x) + bfhi(bq[q][j].x), bflo(a[q][j].y) + bflo(bq[q][j].y), bfhi(a[q][j].y) + bfhi(bq[q][j].y)};
                ss[q][j] = (x[q][j].x * x[q][j].x + x[q][j].y * x[q][j].y) + (x[q][j].z * x[q][j].z + x[q][j].w * x[q][j].w); }
#pragma unroll
        for (int q = 0; q < NR; ++q)
#pragma unroll
            for (int j = 0; j < 4; ++j) ss[q][j] = half_sum(ss[q][j]);
#pragma unroll
        for (int q = 0; q < NR; ++q) {
            if (!ok[q]) continue;
#pragma unroll
            for (int j = 0; j < 4; ++j) {
                const float rstd = rsqrtf(ss[q][j] * (1.f / 128.f) + NORM_EPS);
                const f32x4 o4 = (f32x4){bflo(ov[q][j].x), bfhi(ov[q][j].x), bflo(ov[q][j].y), bfhi(ov[q][j].y)};
                f32x4 y = x[q][j] * rstd * g[j];
                y.x *= sigmoidf_(o4.x); y.y *= sigmoidf_(o4.y); y.z *= sigmoidf_(o4.z); y.w *= sigmoidf_(o4.w);
                u32x2 w; w.x = cvt_pk_bf16(y.x, y.y); w.y = cvt_pk_bf16(y.z, y.w);
                *((u32x2*)(Y + (size_t)row[q] * DM) + F.lane + 64 * j) = w; }
        }
    }
}

constexpr int KVLEN = CTXL + SEQ;
__device__ __forceinline__ void phase_c1b(const Frame& F0) {
    Frame F = refresh(F0);
    const int gw = F.bid * 8 + F.wave, NGW = F.G * 8;
    const bf16_t* P = (const bf16_t*)(WSP(F) + WS_P);
    bf16_t* Qb = (bf16_t*)(WSP(F) + WS_AUX + AUX_QK); bf16_t* Kb = (bf16_t*)(WSP(F) + WS_AUX + AUX_KB); bf16_t* Vb = (bf16_t*)(WSP(F) + WS_AUX + AUX_VB);
    const int l32 = F.lane & 31;
    const f32x4 qg = *((const f32x4*)INP(F, I_AQG) + l32), kg = *((const f32x4*)INP(F, I_AKG) + l32);
    float inv[4];
#pragma unroll
    for (int i = 0; i < 4; ++i) { const int d = 4 * l32 + i; inv[i] = exp2f(-(float)(d & 31) * (13.287712379549449f / 32.f)); }
    const bool second = (l32 & 8) != 0;
    const bool colhalf = l32 >= 16;
    for (int row = gw; row < NTOK; row += NGW) {
        const bool isctx = row < NCTXR;
        const int b = isctx ? (row >> 8) : ((row - NCTXR) >> 12), t = isctx ? (row & 255) : ((row - NCTXR) & 4095);
        const int kvpos = isctx ? t : CTXL + t;
        float cs[4], sn[4];
        { const float pos = (float)(colhalf ? (t & 63) : (t >> 6));
#pragma unroll
          for (int i = 0; i < 4; ++i) { const float ang = pos * inv[i]; cs[i] = isctx ? 1.f : __cosf(ang); sn[i] = isctx ? 0.f : __sinf(ang); } }
        const bf16_t* pr = P + (size_t)row * NPAD_B;
#pragma unroll
        for (int j = 0; j < 6; ++j) {
            const u32x2 w = *((const u32x2*)pr + F.lane + 64 * j);
            f32x4 x = (f32x4){bflo(w.x), bfhi(w.x), bflo(w.y), bfhi(w.y)};
            float ss = (x.x * x.x + x.y * x.y) + (x.z * x.z + x.w * x.w);
            ss = half_sum(ss);
            const float rstd = rsqrtf(ss * (1.f / 128.f) + NORM_EPS);
            x = x * rstd * (j < 4 ? qg : kg);
            float xv[4] = {x.x, x.y, x.z, x.w}, ov[4];
#pragma unroll
            for (int i = 0; i < 4; ++i) { const float pv = xch<8>(xv[i], F.lane);
                ov[i] = second ? (pv * sn[i] + xv[i] * cs[i]) : (xv[i] * cs[i] - pv * sn[i]); }
            u32x2 o; o.x = cvt_pk_bf16(ov[0], ov[1]); o.y = cvt_pk_bf16(ov[2], ov[3]);
            if (j < 4) *((u32x2*)(Qb + (size_t)row * DM) + F.lane + 64 * j) = o;
            else *((u32x2*)(Kb + ((size_t)b * KVLEN + kvpos) * 512) + F.lane + 64 * (j - 4)) = o;
        }
#pragma unroll
        for (int j = 0; j < 2; ++j) *((u32x2*)(Vb + ((size_t)b * KVLEN + kvpos) * 512) + F.lane + 64 * j) = *((const u32x2*)(pr + 1536) + F.lane + 64 * j);
    }
}

namespace att {
constexpr int D = 128, NW = 8, QBLK = 32, KVBLK = 64;
constexpr float SCALE = 0.088388347648318440f;
constexpr float THR = 8.f;
constexpr int LDQ = 1024, LDK = 512, LDO = 1024;
constexpr size_t SHM_V = KVBLK * D * 2, SHM_K = KVBLK * D * 2, SHM_ATTN = 2 * SHM_V + 2 * SHM_K + NW * 64 * 4;
using s16x4 = __attribute__((ext_vector_type(4))) short;
using f32x16 = __attribute__((ext_vector_type(16))) float;
#define KSWZ(row, colB) ((row) * 256 + ((colB) ^ (((row) & 7) << 4)))
#define SBAR() __builtin_amdgcn_sched_barrier(0)
__device__ __forceinline__ int crow(int r, int hi) { return (r & 3) + 8 * (r >> 2) + 4 * hi; }
__device__ __forceinline__ unsigned cvtpk(float lo, float hi) { unsigned r; asm volatile("v_cvt_pk_bf16_f32 %0, %1, %2" : "=v"(r) : "v"(lo), "v"(hi)); return r; }
__device__ __forceinline__ void partialSM(f32x16& p0, f32x16& p1, float& m_reg, float& mn, float& alpha) {
  constexpr float C = SCALE * 1.4426950408889634f;
  float pmax = p0[0]; for (int r = 1; r < 16; ++r) pmax = fmaxf(pmax, p0[r]); for (int r = 0; r < 16; ++r) pmax = fmaxf(pmax, p1[r]);
  { auto rr = __builtin_amdgcn_permlane32_swap(__float_as_uint(pmax), __float_as_uint(pmax), false, false);
    pmax = fmaxf(__uint_as_float(rr[0]), __uint_as_float(rr[1])); }
  if (__builtin_expect(__all(pmax - m_reg <= THR / SCALE), 1)) { mn = m_reg; alpha = 1.f; }
  else { mn = fmaxf(m_reg, pmax); alpha = __builtin_amdgcn_exp2f((m_reg - mn) * C); m_reg = mn; }
  float mnC = -mn * C;
  for (int r = 0; r < 16; ++r) p0[r] = fmaf(p0[r], C, mnC); for (int r = 0; r < 16; ++r) p1[r] = fmaf(p1[r], C, mnC);
  for (int r = 0; r < 16; ++r) p0[r] = __builtin_amdgcn_exp2f(p0[r]);
}
__device__ __forceinline__ void finishSM(f32x16& p0, f32x16& p1, float alpha, float& l_reg, bf16x8& pa0, bf16x8& pa1, bf16x8& pa2, bf16x8& pa3) {
  for (int r = 0; r < 16; ++r) p1[r] = __builtin_amdgcn_exp2f(p1[r]);
  float ps = 0; for (int r = 0; r < 16; ++r) ps += p0[r]; for (int r = 0; r < 16; ++r) ps += p1[r];
  { auto rr = __builtin_amdgcn_permlane32_swap(__float_as_uint(ps), __float_as_uint(ps), false, false);
    ps = __uint_as_float(rr[0]) + __uint_as_float(rr[1]); }
  l_reg = l_reg * alpha + ps;
#define PK4(P, BASE, OUT) do { unsigned a0 = cvtpk(P[BASE + 0], P[BASE + 1]), a1 = cvtpk(P[BASE + 2], P[BASE + 3]);   \
    unsigned b0 = cvtpk(P[BASE + 4], P[BASE + 5]), b1 = cvtpk(P[BASE + 6], P[BASE + 7]);                              \
    auto r0 = __builtin_amdgcn_permlane32_swap(a0, b0, false, false); auto r1 = __builtin_amdgcn_permlane32_swap(a1, b1, false, false); \
    u32x4 w = {r0[0], r1[0], r0[1], r1[1]}; OUT = *reinterpret_cast<bf16x8*>(&w); } while (0)
  PK4(p0, 0, pa0); PK4(p0, 8, pa1); PK4(p1, 0, pa2); PK4(p1, 8, pa3);
#undef PK4
}
__device__ __forceinline__ void qkt(f32x16& p0, f32x16& p1, const bf16_t* Ks, const bf16x8* qr, int r32, int hi) {
  p0 = f32x16{}; p1 = f32x16{};
  for (int d0 = 0; d0 < 8; ++d0) { int cb = (d0 * 16 + hi * 8) * 2;
    bf16x8 b0 = *reinterpret_cast<const bf16x8*>((const char*)Ks + KSWZ(r32, cb));
    bf16x8 b1 = *reinterpret_cast<const bf16x8*>((const char*)Ks + KSWZ(32 + r32, cb));
    p0 = __builtin_amdgcn_mfma_f32_32x32x16_bf16(b0, qr[d0], p0, 0, 0, 0);
    p1 = __builtin_amdgcn_mfma_f32_32x32x16_bf16(b1, qr[d0], p1, 0, 0, 0); }
}
__device__ __forceinline__ int v_st(int k, int c) { const int kk = (k & ~0xC) | ((k & 4) << 1) | ((k & 8) >> 1); return ((kk >> 3) * 4 + (c >> 5)) * 512 + ((kk & 7) * 32 + (c & 31)) * 2; }
__device__ __forceinline__ int v_rd_base(int lane) { return ((lane & 3) << 3) | (((lane >> 2) & 3) << 6) | (((lane >> 4) & 1) << 5) | (((lane >> 5) & 1) << 8); }
constexpr int v_rd_off(int d0, int ks, int half) { return d0 * 512 + ks * 4096 + half * 2048; }
template <int OFF> __device__ __forceinline__ s16x4 tr_read(int vb) {
  s16x4 r; asm volatile("ds_read_b64_tr_b16 %0, %1 offset:%2" : "=&v"(r) : "v"(vb), "i"(OFF) : "memory"); return r;
}
template <int D0> __device__ __forceinline__ void pv_one(f32x16& od, int vb, bf16x8 pa0, bf16x8 pa1, bf16x8 pa2, bf16x8 pa3) {
  const s16x4 l0 = tr_read<v_rd_off(D0, 0, 0)>(vb), h0 = tr_read<v_rd_off(D0, 0, 1)>(vb), l1 = tr_read<v_rd_off(D0, 1, 0)>(vb), h1 = tr_read<v_rd_off(D0, 1, 1)>(vb);
  const s16x4 l2 = tr_read<v_rd_off(D0, 2, 0)>(vb), h2 = tr_read<v_rd_off(D0, 2, 1)>(vb), l3 = tr_read<v_rd_off(D0, 3, 0)>(vb), h3 = tr_read<v_rd_off(D0, 3, 1)>(vb);
  asm volatile("s_waitcnt lgkmcnt(0)" ::: "memory"); SBAR();
#define PK(L, H) (bf16x8){L[0], L[1], L[2], L[3], H[0], H[1], H[2], H[3]}
  od = __builtin_amdgcn_mfma_f32_32x32x16_bf16(pa0, PK(l0, h0), od, 0, 0, 0);
  od = __builtin_amdgcn_mfma_f32_32x32x16_bf16(pa1, PK(l1, h1), od, 0, 0, 0);
  od = __builtin_amdgcn_mfma_f32_32x32x16_bf16(pa2, PK(l2, h2), od, 0, 0, 0);
  od = __builtin_amdgcn_mfma_f32_32x32x16_bf16(pa3, PK(l3, h3), od, 0, 0, 0);
#undef PK
}
__device__ __forceinline__ void pv_d0(f32x16* o, int vb, bf16x8 pa0, bf16x8 pa1, bf16x8 pa2, bf16x8 pa3) {
  pv_one<0>(o[0], vb, pa0, pa1, pa2, pa3); pv_one<1>(o[1], vb, pa0, pa1, pa2, pa3); pv_one<2>(o[2], vb, pa0, pa1, pa2, pa3); pv_one<3>(o[3], vb, pa0, pa1, pa2, pa3);
}
__device__ __forceinline__ void attn_dense_body(const bf16_t* __restrict__ Qb, const bf16_t* __restrict__ Kh, const bf16_t* __restrict__ Vh,
                                                bf16_t* __restrict__ Ob, int seq, char* lds, int wv) {
  int tz_ = wv * 64 + lane_now(); asm volatile("" : "+v"(tz_));
  const int tid = tz_, wid = tid >> 6, lane = tid & 63, r32 = lane & 31, hi = lane >> 5;
  bf16_t* V_lds = (bf16_t*)lds; bf16_t* K_lds = (bf16_t*)(lds + 2 * SHM_V);
  float* ws = (float*)(lds + 2 * SHM_V + 2 * SHM_K) + wid * 64; float* li_l = ws; float* al_l = ws + 32;
  float m_reg = -1e30f, l_reg = 0; f32x16 o[4] = {}; bf16x8 qr[8];
  const bf16_t* Qw = Qb + (long)(wid * QBLK + r32) * LDQ + hi * 8;
#pragma unroll
  for (int d0 = 0; d0 < 8; ++d0) qr[d0] = *reinterpret_cast<const bf16x8*>(Qw + d0 * 16);
  const int sr = tid >> 4, sc = (tid & 15) * 8, vst0 = v_st(sr, sc), vst1 = v_st(32 + sr, sc);
  const int vb0 = (int)(uintptr_t)V_lds + v_rd_base(lane);
  struct { bf16x8 vs0, vs1, ks0, ks1; } sr_[2];
#define SLOAD(i, k0) do { sr_[i].vs0 = *reinterpret_cast<const bf16x8*>(&Vh[(long)((k0) + sr) * LDK + sc]); sr_[i].vs1 = *reinterpret_cast<const bf16x8*>(&Vh[(long)((k0) + 32 + sr) * LDK + sc]); \
    sr_[i].ks0 = *reinterpret_cast<const bf16x8*>(&Kh[(long)((k0) + sr) * LDK + sc]); sr_[i].ks1 = *reinterpret_cast<const bf16x8*>(&Kh[(long)((k0) + 32 + sr) * LDK + sc]); } while (0)
#define SWRITE(b, i) do { *(bf16x8*)((char*)V_lds + (b) * SHM_V + vst0) = sr_[i].vs0;          \
    *(bf16x8*)((char*)V_lds + (b) * SHM_V + vst1) = sr_[i].vs1; int kc = sc * 2;               \
    *(bf16x8*)((char*)K_lds + (b) * SHM_K + KSWZ(sr, kc)) = sr_[i].ks0;                       \
    *(bf16x8*)((char*)K_lds + (b) * SHM_K + KSWZ(32 + sr, kc)) = sr_[i].ks1; } while (0)
#define SWAIT() asm volatile("s_waitcnt vmcnt(4)" ::: "memory")
#define RESC(a) do { if (__any((a) < 1.f)) { if (hi == 0) al_l[r32] = (a); asm volatile("s_waitcnt lgkmcnt(0)" ::: "memory"); \
    for (int d = 0; d < 4; ++d) for (int r = 0; r < 16; ++r) o[d][r] *= al_l[crow(r, hi)]; } } while (0)
  f32x16 pA0, pA1, pB0, pB1; float mnA, mnB, alA, alB; bf16x8 pa0, pa1, pa2, pa3; const int NT = seq / KVBLK;
  constexpr int SE = 0, SO = 1;
  SLOAD(SE, 0); asm volatile("s_waitcnt vmcnt(0)" ::: "memory"); SWRITE(0, SE); __syncthreads();
  qkt(pA0, pA1, K_lds, qr, r32, hi); partialSM(pA0, pA1, m_reg, mnA, alA);
  SLOAD(SO, KVBLK); if (2 < NT) SLOAD(SE, 2 * KVBLK);
  SWAIT(); SWRITE(1, SO); __syncthreads();
  for (int j = 1; j + 1 < NT; j += 2) {
    SBAR(); qkt(pB0, pB1, (bf16_t*)((char*)K_lds + SHM_K), qr, r32, hi);
    finishSM(pA0, pA1, alA, l_reg, pa0, pa1, pa2, pa3); SBAR();
    SLOAD(SO, (j + 2) * KVBLK); SBAR();
    pv_d0(o, vb0, pa0, pa1, pa2, pa3); partialSM(pB0, pB1, m_reg, mnB, alB);
    __syncthreads(); SWAIT(); SWRITE(0, SE);
    RESC(alB); __syncthreads();
    SBAR(); qkt(pA0, pA1, K_lds, qr, r32, hi);
    finishSM(pB0, pB1, alB, l_reg, pa0, pa1, pa2, pa3); SBAR();
    if (j + 3 < NT) SLOAD(SE, (j + 3) * KVBLK); SBAR();
    pv_d0(o, vb0 + (int)SHM_V, pa0, pa1, pa2, pa3); partialSM(pA0, pA1, m_reg, mnA, alA);
    __syncthreads(); SWAIT(); SWRITE(1, SO);
    RESC(alA); __syncthreads();
  }
  SBAR(); qkt(pB0, pB1, (bf16_t*)((char*)K_lds + SHM_K), qr, r32, hi);
  finishSM(pA0, pA1, alA, l_reg, pa0, pa1, pa2, pa3); SBAR();
  pv_d0(o, vb0, pa0, pa1, pa2, pa3); partialSM(pB0, pB1, m_reg, mnB, alB);
  __syncthreads(); RESC(alB);
  finishSM(pB0, pB1, alB, l_reg, pa0, pa1, pa2, pa3); SBAR();
  pv_d0(o, vb0 + (int)SHM_V, pa0, pa1, pa2, pa3);
  if (hi == 0) li_l[r32] = l_reg; asm volatile("s_waitcnt lgkmcnt(0)" ::: "memory");
  float rli[16];
#pragma unroll
  for (int r = 0; r < 16; ++r) rli[r] = __builtin_amdgcn_rcpf(li_l[crow(r, hi)]);
  bf16_t* Ow = Ob + (long)(wid * QBLK) * LDO;
#pragma unroll
  for (int r = 0; r < 16; ++r) { int orow = crow(r, hi);
    for (int d0 = 0; d0 < 4; ++d0) Ow[(long)orow * LDO + d0 * 32 + r32] = f2bf(o[d0][r] * rli[r]); }
#undef SLOAD
#undef SWRITE
#undef SWAIT
#undef RESC
}
#undef KSWZ
#undef SBAR
}

__device__ __forceinline__ void phase_c2b(const Frame& F0) {
    Frame F = refresh(F0);
    const bf16_t* Qb = (const bf16_t*)(WSP(F) + WS_AUX + AUX_QK); const bf16_t* Kb = (const bf16_t*)(WSP(F) + WS_AUX + AUX_KB); const bf16_t* Vb = (const bf16_t*)(WSP(F) + WS_AUX + AUX_VB);
    bf16_t* Y = (bf16_t*)(WSP(F) + WS_YPRE);
    for (int i = 0; i < 3; ++i) {
        int b, h, seq; size_t qrow;
        if (i < 2) { const int x = F.bid & 7, j = F.bid >> 3, g = 8 * i + x; b = g >> 2; h = (g & 3) * 2 + (j >> 4); qrow = (size_t)NCTXR + (size_t)b * SEQ + (size_t)(j & 15) * 256; seq = KVLEN; }
        else { if (F.bid >= 32) break; b = F.bid >> 3; h = F.bid & 7; qrow = (size_t)b * CTXL; seq = CTXL; }
        const size_t kvoff = (size_t)b * KVLEN * 512 + (size_t)(h >> 1) * 128;
        att::attn_dense_body(Qb + qrow * DM + h * 128, Kb + kvoff, Vb + kvoff, Y + qrow * DM + h * 128, seq, (char*)(unsigned char*)F.lds, F.wave);
        __syncthreads();
    }
}

__device__ __forceinline__ void phase_c1c(const Frame& F0) {
    Frame F = refresh(F0);
    const bf16_t* P = (const bf16_t*)(WSP(F) + WS_P);
    LAS float* alow = (LAS float*)F.lds;
    const int c = F.tid;
    for (int it = F.bid; it < (NTOK / 64) * 2; it += F.G) {
        const int tc = it >> 1, dir = it & 1, row0 = tc * 64;
        bf16_t* QT = (bf16_t*)(WSP(F) + WS_AUX + AUX_QT) + (size_t)dir * NTOK * 512;
        bf16_t* KH = (bf16_t*)(WSP(F) + WS_AUX + AUX_KHT) + (size_t)dir * NTOK * 512;
        float* DEC = (float*)(WSP(F) + WS_AUX + AUX_DEC) + (size_t)(dir * (NTOK / 64) + tc) * 512;
        __syncthreads();
        for (int i = F.tid; i < 1024; i += 512) { const int t = i >> 4, r = i & 15; alow[i] = bf2f(P[(size_t)(row0 + t) * NPAD_A + 3072 + dir * 16 + r]); }
        float w2[16];
#pragma unroll
        for (int r = 0; r < 16; ++r) w2[r] = INP(F, I_GAW2)[(size_t)(dir * 16 + r) * 512 + c];
        const float ab = INP(F, I_GAB)[dir * 512 + c];
        __syncthreads();
        float tot = 0.f, lav[64];
#pragma unroll
        for (int t = 0; t < 64; ++t) { float s_ = ab;
#pragma unroll
            for (int r = 0; r < 16; ++r) s_ += alow[t * 16 + r] * w2[r];
            lav[t] = logsigmoidf_(s_) * (1.f / 16.f); tot += lav[t]; }
        float pex = 0.f;
        bf16_t qn[16], kn[16];
#pragma unroll
        for (int i = 0; i < 16; ++i) { qn[i] = P[(size_t)(row0 + i) * NPAD_A + c]; kn[i] = P[(size_t)(row0 + i) * NPAD_A + 512 + c]; }
#pragma unroll
        for (int g = 0; g < 4; ++g) {
            bf16_t qc[16], kc[16];
#pragma unroll
            for (int i = 0; i < 16; ++i) { qc[i] = qn[i]; kc[i] = kn[i]; }
            if (g < 3) {
#pragma unroll
                for (int i = 0; i < 16; ++i) { qn[i] = P[(size_t)(row0 + 16 * (g + 1) + i) * NPAD_A + c]; kn[i] = P[(size_t)(row0 + 16 * (g + 1) + i) * NPAD_A + 512 + c]; } }
#pragma unroll
            for (int i = 0; i < 16; ++i) {
                const int t = 16 * g + i;
                const float la = lav[t];
                const float bb = dir ? (tot - pex) : (pex + la);
                pex += la;
                const size_t row = (size_t)(row0 + t);
                const float q = bf2f(qc[i]) * 0.08838834764831845f, k = bf2f(kc[i]);
                QT[row * 512 + c] = f2bf(q * __expf(bb - tot)); KH[row * 512 + c] = f2bf(k * __expf(tot - bb));
            }
        }
        DEC[c] = __expf(tot);
    }
}

__device__ __forceinline__ void phase_c2c(const Frame& F0, bool last_layer, int cl0, int cl1) {
    Frame F = refresh(F0);
    if (F.bid >= 64) { if (cl1 > cl0) moe_convert(F, cl0, cl1, (F.bid - 64) * 8 + F.wave, (F.G - 64) * 8); return; }
    const int b = F.bid >> 4, h = (F.bid >> 2) & 3, dir = (F.bid >> 1) & 1, vh = F.bid & 1;
    constexpr int LQ = 136, LD = 72, LH = 136, NCH = (CTXL + SEQ) / 64;
    constexpr int OFF_KH = 64 * LQ * 2, OFF_V = OFF_KH + 16384, OFF_DEC = OFF_V + 16384, IN_BYTES = OFF_DEC + 512;
    constexpr int OFF_SB = 2 * IN_BYTES, OFF_HS = OFF_SB + 64 * LD * 2, LDS_USED = OFF_HS + 64 * LH * 2;
    static_assert(LDS_USED <= MISC_OFF, "C2c LDS map");
    LAS unsigned char* L0 = F.lds;
    LAS bf16_t* Sb = (LAS bf16_t*)(L0 + OFF_SB); LAS bf16_t* Hs = (LAS bf16_t*)(L0 + OFF_HS);
    { LAS unsigned* z = (LAS unsigned*)L0; for (int i = F.tid; i < LDS_USED / 4; i += 512) z[i] = 0u; }
    const bf16_t* QT = (const bf16_t*)(WSP(F) + WS_AUX + AUX_QT) + (size_t)dir * NTOK * 512;
    const bf16_t* KH = (const bf16_t*)(WSP(F) + WS_AUX + AUX_KHT) + (size_t)dir * NTOK * 512;
    const float* DEC = (const float*)(WSP(F) + WS_AUX + AUX_DEC) + (size_t)dir * (NTOK / 64) * 512;
    const bf16_t* P = (const bf16_t*)(WSP(F) + WS_P);
    bf16_t* HD = (bf16_t*)(WSP(F) + WS_HDIR) + (size_t)dir * NTOK * DM;
    const int fr = F.lane & 15, fq = F.lane >> 4;
    u32x4 rq[2], rh[2], rv[2]; float rd = 0.f;
#define C2C_LOAD(c) do { const int c_ = (c); const int p0_ = c_ * 64; \
        const int tc_ = (c_ < 4) ? (b * 4 + (dir ? 3 - c_ : c_)) : (16 + b * 64 + (dir ? 63 - (c_ - 4) : (c_ - 4))); \
        _Pragma("unroll") for (int i = 0; i < 2; ++i) { const int pc = F.tid + 512 * i, r_ = pc >> 4, ch_ = pc & 15; const size_t row_ = (size_t)scan_row(b, dir, p0_ + r_); \
            rq[i] = *(const u32x4*)(QT + row_ * 512 + h * 128 + ch_ * 8); rh[i] = *(const u32x4*)(KH + row_ * 512 + h * 128 + ch_ * 8); \
            rv[i] = *(const u32x4*)(P + row_ * NPAD_A + 1024 + h * 256 + vh * 128 + ch_ * 8); } \
        if (F.tid < 128) rd = DEC[(size_t)tc_ * 512 + h * 128 + F.tid]; } while (0)
#define C2C_STAGE(buf) do { LAS unsigned char* B_ = L0 + (buf) * IN_BYTES; \
        _Pragma("unroll") for (int i = 0; i < 2; ++i) { const int pc = F.tid + 512 * i, r_ = pc >> 4, ch_ = pc & 15; \
            *(LAS u32x4*)(B_ + (r_ * LQ + ch_ * 8) * 2) = rq[i]; *(LAS u32x4*)(B_ + OFF_KH + off_b(r_, ch_)) = rh[i]; *(LAS u32x4*)(B_ + OFF_V + off_b(r_, ch_)) = rv[i]; } \
        if (F.tid < 128) ((LAS float*)(B_ + OFF_DEC))[F.tid] = rd; } while (0)
    __syncthreads();
    C2C_LOAD(0); C2C_STAGE(0); C2C_LOAD(1);
    f32x4 ST[8];
#pragma unroll
    for (int i = 0; i < 8; ++i) ST[i] = (f32x4){0.f, 0.f, 0.f, 0.f};
    const unsigned lbase = (unsigned)(size_t)L0;
    for (int c = 0; c <= NCH; ++c) {
        __syncthreads();
        const int buf = c & 1;
        if (c + 1 < NCH) C2C_STAGE(buf ^ 1);
        if (c > 0 && !(last_layer && c - 1 < CTXL / 64)) {
            const int row0 = scan_row(b, dir, (c - 1) * 64), rstep = dir ? -1 : 1;
#pragma unroll
            for (int i = 0; i < 2; ++i) { const int pc = F.tid + 512 * i, r_ = pc >> 4, ch_ = pc & 15;
                *(u32x4*)(HD + (size_t)(row0 + rstep * r_) * DM + h * 256 + vh * 128 + ch_ * 8) = *(const LAS u32x4*)(Hs + r_ * LH + ch_ * 8); }
        }
        if (c == NCH) break;
        if (c + 2 < NCH) C2C_LOAD(c + 2);
        const LAS bf16_t* Qs = (const LAS bf16_t*)(L0 + buf * IN_BYTES);
        const LAS unsigned char* KHi = L0 + buf * IN_BYTES + OFF_KH;
        const LAS float* decs = (const LAS float*)(L0 + buf * IN_BYTES + OFF_DEC);
        for (int id = F.wave; id < 10; id += 8) {
            int ti, si; tri_tile(id, ti, si);
            f32x4 acc = (f32x4){0.f, 0.f, 0.f, 0.f};
#pragma unroll
            for (int kk = 0; kk < 4; ++kk) acc = MMA16(lds_frag(Qs, LQ, ti * 16, kk * 32, fr, fq), *(const LAS bf16x8*)(KHi + off_b(si * 16 + fr, 4 * kk + fq)), acc);
            const int s_ = si * 16 + fr;
#pragma unroll
            for (int j = 0; j < 4; ++j) { const int t = ti * 16 + fq * 4 + j; Sb[t * LD + s_] = f2bf((s_ <= t) ? acc[j] : 0.f); }
        }
        __syncthreads();
        const unsigned vbase = lbase + buf * IN_BYTES + OFF_V, kbase = lbase + buf * IN_BYTES + OFF_KH;
        s16x4 v00 = tr_read(vbase + tr_addr16(F.lane, F.wave, 0, 0)), v01 = tr_read(vbase + tr_addr16(F.lane, F.wave, 0, 1));
        s16x4 v10 = tr_read(vbase + tr_addr16(F.lane, F.wave, 1, 0)), v11 = tr_read(vbase + tr_addr16(F.lane, F.wave, 1, 1));
        TR_WAIT2(v00, v01); TR_WAIT2(v10, v11);
        const bf16x8 vf0 = cat4(v00, v01), vf1 = cat4(v10, v11);
#pragma unroll
        for (int di = 0; di < 8; ++di) ST[di] = ST[di] * *(const LAS f32x4*)(decs + di * 16 + fq * 4);
        bf16x8 sbf[4];
#pragma unroll
        for (int kk = 0; kk < 4; ++kk) {
            u32x4 w; w.x = cvt_pk_bf16(ST[2 * kk][0], ST[2 * kk][1]); w.y = cvt_pk_bf16(ST[2 * kk][2], ST[2 * kk][3]); w.z = cvt_pk_bf16(ST[2 * kk + 1][0], ST[2 * kk + 1][1]); w.w = cvt_pk_bf16(ST[2 * kk + 1][2], ST[2 * kk + 1][3]);
            sbf[kk] = __builtin_bit_cast(bf16x8, w); }
#pragma unroll
        for (int ti = 0; ti < 4; ++ti) {
            f32x4 a = (f32x4){0.f, 0.f, 0.f, 0.f};
#pragma unroll
            for (int kk = 0; kk < 4; ++kk) {
                const u32x2 qlo = *(const LAS u32x2*)(Qs + (ti * 16 + fr) * LQ + kk * 32 + 4 * fq), qhi = *(const LAS u32x2*)(Qs + (ti * 16 + fr) * LQ + kk * 32 + 16 + 4 * fq);
                const u32x4 qw = (u32x4){qlo.x, qlo.y, qhi.x, qhi.y};
                a = MMA16(__builtin_bit_cast(bf16x8, qw), sbf[kk], a); }
            a = MMA16(lds_frag(Sb, LD, ti * 16, 0, fr, fq), vf0, a);
            if (ti >= 2) a = MMA16(lds_frag(Sb, LD, ti * 16, 32, fr, fq), vf1, a);
#pragma unroll
            for (int j = 0; j < 4; ++j) Hs[(ti * 16 + fq * 4 + j) * LH + F.wave * 16 + fr] = f2bf(a[j]);
        }
#pragma unroll
        for (int dg = 0; dg < 2; ++dg) {
            s16x4 kq[4][4];
#pragma unroll
            for (int i = 0; i < 4; ++i) { const int di = dg * 4 + i; kq[i][0] = tr_read(kbase + tr_addr16(F.lane, di, 0, 0)); kq[i][1] = tr_read(kbase + tr_addr16(F.lane, di, 0, 1));
                kq[i][2] = tr_read(kbase + tr_addr16(F.lane, di, 1, 0)); kq[i][3] = tr_read(kbase + tr_addr16(F.lane, di, 1, 1)); }
#pragma unroll
            for (int i = 0; i < 4; ++i) { TR_WAIT2(kq[i][0], kq[i][1]); TR_WAIT2(kq[i][2], kq[i][3]); }
#pragma unroll
            for (int i = 0; i < 4; ++i) { const int di = dg * 4 + i; f32x4 a = ST[di];
                a = MMA16(cat4(kq[i][0], kq[i][1]), vf0, a); a = MMA16(cat4(kq[i][2], kq[i][3]), vf1, a); ST[di] = a; }
        }
    }
#undef C2C_LOAD
#undef C2C_STAGE
}

__device__ __forceinline__ void phase_c3c(const Frame& F0) {
    Frame F = refresh(F0);
    const int gw = F.bid * 8 + F.wave, NGW = F.G * 8;
    const bf16_t* P = (const bf16_t*)(WSP(F) + WS_P);
    const bf16_t* H0 = (const bf16_t*)(WSP(F) + WS_HDIR); const bf16_t* H1 = H0 + (size_t)NTOK * DM;
    bf16_t* Y = (bf16_t*)(WSP(F) + WS_YPRE);
    const float* ng = INP(F, I_GNG);
    f32x4 g[4];
#pragma unroll
    for (int j = 0; j < 4; ++j) g[j] = *((const f32x4*)ng + F.lane + 64 * j);
    constexpr int NR = 4;
    for (int row0 = gw; row0 < NTOK; row0 += NR * NGW) {
        int row[NR]; bool ok[NR]; u32x2 a[NR][4], bq[NR][4], gv[NR][4];
#pragma unroll
        for (int q = 0; q < NR; ++q) { row[q] = row0 + q * NGW; ok[q] = row[q] < NTOK; if (!ok[q]) row[q] = row0;
#pragma unroll
            for (int j = 0; j < 4; ++j) {
                a[q][j] = *((const u32x2*)(H0 + (size_t)row[q] * DM) + F.lane + 64 * j); bq[q][j] = *((const u32x2*)(H1 + (size_t)row[q] * DM) + F.lane + 64 * j);
                gv[q][j] = *((const u32x2*)(P + (size_t)row[q] * NPAD_A + 2048) + F.lane + 64 * j); } }
        f32x4 x[NR][4]; float ss[NR][4];
#pragma unroll
        for (int q = 0; q < NR; ++q)
#pragma unroll
            for (int j = 0; j < 4; ++j) { x[q][j] = (f32x4){bflo(a[q][j].x) + bflo(bq[q][j].x), bfhi(a[q][j].x) + bfhi(bq[q][j].x), bflo(a[q][j].y) + bflo(bq[q][j].y), bfhi(a[q][j].y) + bfhi(bq[q][j].y)};
                ss[q][j] = (x[q][j].x * x[q][j].x + x[q][j].y * x[q][j].y) + (x[q][j].z * x[q][j].z + x[q][j].w * x[q][j].w); }
#pragma unroll
        for (int q = 0; q < NR; ++q)
#pragma unroll
            for (int j = 0; j < 4; ++j) ss[q][j] = wave_sum(ss[q][j], F.lane);
#pragma unroll
        for (int q = 0; q < NR; ++q) {
            if (!ok[q]) continue;
#pragma unroll
            for (int j = 0; j < 4; ++j) {
                const float rstd = rsqrtf(ss[q][j] * (1.f / 256.f) + NORM_EPS);
                const f32x4 g4 = (f32x4){bflo(gv[q][j].x), bfhi(gv[q][j].x), bflo(gv[q][j].y), bfhi(gv[q][j].y)};
                f32x4 y = x[q][j] * rstd * g[j];
                y.x *= g4.x * sigmoidf_(g4.x); y.y *= g4.y * sigmoidf_(g4.y); y.z *= g4.z * sigmoidf_(g4.z); y.w *= g4.w * sigmoidf_(g4.w);
                u32x2 w; w.x = cvt_pk_bf16(y.x, y.y); w.y = cvt_pk_bf16(y.z, y.w);
                *((u32x2*)(Y + (size_t)row[q] * DM) + F.lane + 64 * j) = w; }
        }
    }
}

#ifndef PHSEL
#define PHSEL 0xFFFF
#endif
#define SEL(n) ((PHSEL >> (n)) & 1)
constexpr int N_PHASES = 42;
__global__ void __launch_bounds__(512, 2) mk_fwd(Args args) {
    extern __shared__ __attribute__((aligned(16))) unsigned char lds[];
    Frame F;
    F.lds = (LAS unsigned char*)lds;
    F.tid = threadIdx.x; F.lane = F.tid & 63; F.wave = __builtin_amdgcn_readfirstlane(F.tid >> 6);
    F.G = gridDim.x; F.bid = blockIdx.x;
    F.ka = (const CAS char*)__builtin_amdgcn_kernarg_segment_ptr();
    F.out_ = *(GAS float* const CAS*)(F.ka + 224); F.ws_ = *(GAS unsigned char* const CAS*)(F.ka + 232);
    volatile LAS unsigned* misc = (volatile LAS unsigned*)(F.lds + MISC_OFF);
    if (F.tid < 4) misc[F.tid] = 0u;
    __syncthreads();
    unsigned* ctl = (unsigned*)(WSP(F) + WS_CTL);
    XcdBarrier bar; bar.bar = ctl + CW_BAR; bar.x = 0; bar.st = misc; bar.wave = F.wave;
    const int lo = args.ph_lo, hi = args.ph_hi;
    if (hi - lo > 1) bar = xcd_barrier_post(ctl + CW_BAR, misc, F.wave);
#define IN(k) (lo <= (k) && (k) < hi)
#define END(k) do { if ((k) + 1 < hi) xcd_barrier(bar); } while (0)

    if (SEL(0) && IN(0)) { phase_p0(F); END(0); }
    for (int l = 0; l < DEPTH; ++l) {
        const int base = 1 + 10 * l, kind = l % 3, jl = l / 3;
        const int npad = (kind == 1) ? NPAD_B : NPAD_A;
        if (SEL(1) && IN(base + 0)) { phase_a(F, l); END(base + 0); }
        if (SEL(2) && IN(base + 1)) {
            g8::StaticSched S; S.init(WSP(F) + WS_U, WSP(F) + WS_WIN + (size_t)l * 7 * MiB, NTOK, npad, F.G, F.bid);
            g8::EpiBf16 E{(bf16_t*)(WSP(F) + WS_P), npad};
            g8::gemm_phase(F.lds, S, E, (const char*)WSP(F), F.wave);
            END(base + 1);
        }
        if (kind == 0) {
            if (SEL(3) && IN(base + 2)) { phase_c1a(F, jl); END(base + 2); }
            if (SEL(4) && IN(base + 3)) { phase_c2a(F, l == DEPTH - 1, l == 0 ? 0 : 3, l == 0 ? 2 : 4); END(base + 3); }
            if (SEL(5) && IN(base + 4)) { phase_c3a(F, jl); END(base + 4); }
        } else if (kind == 1) {
            if (SEL(6) && IN(base + 2)) { phase_c1b(F); END(base + 2); }
            if (SEL(7) && IN(base + 3)) { phase_c2b(F); END(base + 3); }
        } else {
            if (SEL(8) && IN(base + 2)) { phase_c1c(F); END(base + 2); }
            if (SEL(9) && IN(base + 3)) { phase_c2c(F, l == DEPTH - 1, 2, 3); END(base + 3); }
            if (SEL(10) && IN(base + 4)) { phase_c3c(F); END(base + 4); }
        }
        if (SEL(11) && IN(base + 5)) {
            const bool lastl = (l == DEPTH - 1);
            g8::StaticSched S; S.init(WSP(F) + WS_YPRE, WSP(F) + WS_WOUT + (size_t)l * 2 * MiB, lastl ? NLATR : NTOK, DM, F.G, F.bid, lastl ? NCTXR : 0);
            g8::EpiDelta E{(bf16_t*)(WSP(F) + WS_DELTA), (const float*)(WSP(F) + WS_MODV) + (size_t)(l * 5) * 6144 + 2 * 1024};
            g8::gemm_phase(F.lds, S, E, (const char*)WSP(F), F.wave);
            END(base + 5);
        }
        if (SEL(12) && IN(base + 6)) { phase_e(F, l); END(base + 6); }
        if (SEL(13) && IN(base + 7)) {
            moe_tstart_table(F, l);
            const LAS int* tab = (const LAS int*)(F.lds + TAB_OFF);
            g8::MoeSched<true> S{(const char*)(WSP(F) + WS_U), (const char*)(WSP(F) + WS_WGU) + (size_t)l * 32 * 2048 * 1024, (const int*)(WSP(F) + WS_SLOTTOK), tab, __builtin_amdgcn_readfirstlane(tab[64]) * 8, F.G, F.bid};
            g8::EpiSwiglu E{WSP(F) + WS_HDN, INP(F, I_BGU) + (size_t)l * 32 * 2048};
            g8::gemm_phase(F.lds, S, E, (const char*)WSP(F), F.wave);
            END(base + 7);
        }
        if (SEL(14) && IN(base + 8)) {
            moe_tstart_table(F, l);
            const LAS int* tab = (const LAS int*)(F.lds + TAB_OFF);
            g8::MoeSched<false> S{(const char*)(WSP(F) + WS_HDN), (const char*)(WSP(F) + WS_WD) + (size_t)l * 32 * 1024 * 1024, (const int*)(WSP(F) + WS_SLOTTOK), tab, __builtin_amdgcn_readfirstlane(tab[64]) * 4, F.G, F.bid};
            g8::EpiDown E{(bf16_t*)(WSP(F) + WS_Y2), INP(F, I_BD) + (size_t)l * 32 * 1024};
            g8::gemm_phase(F.lds, S, E, (const char*)WSP(F), F.wave);
            END(base + 8);
        }
    }
    if (SEL(1) && IN(41)) phase_a(F, 4);
#if defined(DBG_STOP)
    if (lo == 100 && (long)DBG_DUMP_OFF >= 0) {
        const size_t n = (size_t)NLATR * DM; float* o = OUTP(F);
        for (size_t i = (size_t)F.bid * 512 + F.tid; i < n; i += (size_t)F.G * 512) {
            float acc = 0.f;
            for (size_t j = i; j < (size_t)DBG_DUMP_TOTAL; j += n) {
                if (DBG_DUMP_BF16) acc += bf2f(((const bf16_t*)(WSP(F) + (size_t)DBG_DUMP_OFF))[j]);
                else acc += ((const float*)(WSP(F) + (size_t)DBG_DUMP_OFF))[j]; }
            o[i] = acc;
        }
    }
#endif
#undef IN
#undef END
}

extern "C" void kernel_launch(void* const* d_in, const int* in_sizes, int n_in, void* d_out, int out_size, void* d_ws, size_t ws_size, hipStream_t stream) {
    static int ready = 0;
    if (ready == 0) {
        if (n_in != 28 || out_size != NLATR * DM || ws_size < WS_END) { fprintf(stderr, "kernel_launch: unexpected shapes (n_in %d out %d ws %zu)\n", n_in, out_size, ws_size); ready = -1; return; }
        if (hipFuncSetAttribute((const void*)mk_fwd, hipFuncAttributeMaxDynamicSharedMemorySize, LDS_BYTES) != hipSuccess) { fprintf(stderr, "kernel_launch: hipFuncSetAttribute failed\n"); ready = -1; return; }
        int per_cu = 0;
        if (hipOccupancyMaxActiveBlocksPerMultiprocessor(&per_cu, (const void*)mk_fwd, 512, LDS_BYTES) != hipSuccess || per_cu < 1)
            fprintf(stderr, "kernel_launch: occupancy query reports %d workgroups per CU\n", per_cu);
        (void)hipGetLastError();
        ready = 1;
    }
    if (ready < 0) return;
    (void)hipMemsetAsync((char*)d_ws + WS_CTL, 0, CTL_ZERO_BYTES, stream);
    Args a{};
    for (int i = 0; i < 28; ++i) a.in[i] = (const float*)d_in[i];
    a.out = (float*)d_out; a.ws = (unsigned char*)d_ws;
#if MK_MULTI
#if defined(DBG_STOP)
    for (int k = 0; k <= DBG_STOP; ++k) {
#else
    for (int k = 0; k < N_PHASES; ++k) {
#endif
        const int l = (k - 1) / 10, j = (k - 1) % 10;
        if (k > 0 && k < 41) { if (j == 9) continue; if (j == 4 && (l % 3) == 1) continue; }
        a.ph_lo = k; a.ph_hi = k + 1;
        hipLaunchKernelGGL(mk_fwd, dim3(256), dim3(512), LDS_BYTES, stream, a);
    }
#if defined(DBG_STOP)
    a.ph_lo = 100; a.ph_hi = 101;
    hipLaunchKernelGGL(mk_fwd, dim3(256), dim3(512), LDS_BYTES, stream, a);
#endif
#else
    a.ph_lo = 0; a.ph_hi = N_PHASES;
    hipLaunchKernelGGL(mk_fwd, dim3(256), dim3(512), LDS_BYTES, stream, a);
#endif
    const hipError_t le = hipPeekAtLastError();
    if (le != hipSuccess) fprintf(stderr, "kernel_launch: launch failed: %s\n", hipGetErrorName(le));
}
```

```cpp
#include <hip/hip_runtime.h>
#include <cstdio>
#include <cstdint>
#include <cstddef>

#ifndef MK_MULTI
#define MK_MULTI 0
#endif

#define GAS __attribute__((address_space(1)))
#define LAS __attribute__((address_space(3)))
typedef unsigned short bf16_t;
typedef short bf16x8 __attribute__((ext_vector_type(8)));
typedef float f32x4 __attribute__((ext_vector_type(4)));
typedef float f32x2 __attribute__((ext_vector_type(2)));
typedef unsigned u32x4 __attribute__((ext_vector_type(4)));
typedef unsigned u32x2 __attribute__((ext_vector_type(2)));

constexpr int DM = 1024, NBATCH = 4, SEQ = 4096, CTXL = 256, DEPTH = 4;
constexpr int NCTXR = NBATCH * CTXL;
constexpr int NLATR = NBATCH * SEQ;
constexpr int NTOK = NCTXR + NLATR;
constexpr int NEXP = 32, TOPK = 4;
constexpr int NPAD_A = 3328, NPAD_B = 2048;
constexpr int MAXTILES = 304;
constexpr float NORM_EPS = 1e-6f;

constexpr size_t MiB = 1u << 20;
constexpr size_t WS_CTL = 0, CTL_ZERO_BYTES = 1 * MiB;
constexpr size_t WS_MODV = 1 * MiB;
constexpr size_t WS_ROUTW = 3 * MiB;
constexpr size_t WS_TOKREC = 4 * MiB;
constexpr size_t WS_SLOTTOK = 5 * MiB;
constexpr size_t WS_HCTX = 8 * MiB;
constexpr size_t WS_HB = 600 * MiB;
constexpr size_t WS_GATES = 360 * MiB;
constexpr size_t WS_WIN = 16 * MiB;
constexpr size_t WS_WOUT = 48 * MiB;
constexpr size_t WS_U = 64 * MiB;
constexpr size_t WS_P = 128 * MiB;
constexpr size_t WS_AUX = 240 * MiB;
constexpr size_t WS_HDIR = 400 * MiB;
constexpr size_t WS_DELTA = WS_HDIR;
constexpr size_t WS_YPRE = 480 * MiB;
constexpr size_t WS_HDN = 520 * MiB;
constexpr size_t WS_Y2 = 680 * MiB;
constexpr size_t WS_WGU = 1024 * MiB;
constexpr size_t WS_WD = 1536 * MiB;
constexpr size_t WS_END = 1792 * MiB;
constexpr size_t AUX_QK = 0;
constexpr size_t AUX_KB = 40 * MiB;
constexpr size_t AUX_VB = 60 * MiB;
constexpr size_t AUX_QT = 0;
constexpr size_t AUX_KT = 36 * MiB;
constexpr size_t AUX_KHT = 72 * MiB;
constexpr size_t AUX_DEC = 108 * MiB;
constexpr int CW_BAR = 4096;
constexpr int CW_CNT = 16384;

constexpr int LDS_BYTES = 147456;
constexpr int TAB_OFF = 131072;
constexpr int MISC_OFF = LDS_BYTES - 16;

typedef __bf16 bf16x2_t __attribute__((ext_vector_type(2)));
__device__ __forceinline__ unsigned cvt_pk_bf16(float lo, float hi) { f32x2 v = {lo, hi}; bf16x2_t r = __builtin_convertvector(v, bf16x2_t); return __builtin_bit_cast(unsigned, r); }
__device__ __forceinline__ bf16_t f2bf(float f) { return (bf16_t)(cvt_pk_bf16(f, 0.f) & 0xffffu); }
__device__ __forceinline__ float bf2f(bf16_t b) { return __uint_as_float(((unsigned)b) << 16); }
__device__ __forceinline__ float bflo(unsigned w) { return __uint_as_float(w << 16); }
__device__ __forceinline__ float bfhi(unsigned w) { return __uint_as_float(w & 0xffff0000u); }
__device__ __forceinline__ float shx(float v, int mask, int lane) { return __int_as_float(__builtin_amdgcn_ds_bpermute((lane ^ mask) << 2, __float_as_int(v))); }
__device__ __forceinline__ int shxi(int v, int mask, int lane) { return __builtin_amdgcn_ds_bpermute((lane ^ mask) << 2, v); }
__device__ __forceinline__ float shup(float v, int d, int lane) { const int src = lane >= d ? lane - d : lane; return __int_as_float(__builtin_amdgcn_ds_bpermute(src << 2, __float_as_int(v))); }
__device__ __forceinline__ float shdn(float v, int d, int lane) { const int src = lane + d < 64 ? lane + d : lane; return __int_as_float(__builtin_amdgcn_ds_bpermute(src << 2, __float_as_int(v))); }
__device__ __forceinline__ float shidx(float v, int src) { return __int_as_float(__builtin_amdgcn_ds_bpermute(src << 2, __float_as_int(v))); }
template <int CTRL> __device__ __forceinline__ float dpp(float x) { return __builtin_bit_cast(float, __builtin_amdgcn_mov_dpp(__builtin_bit_cast(int, x), CTRL, 0xf, 0xf, true)); }
constexpr int DPP_XOR1 = 0xB1, DPP_XOR2 = 0x4E, DPP_XOR7 = 0x141, DPP_XOR8 = 0x128, DPP_ROR4 = 0x124, DPP_XOR3 = 0x1B;
__device__ __forceinline__ float row16_sum(float x) { x += dpp<DPP_XOR1>(x); x += dpp<DPP_XOR2>(x); x += dpp<DPP_ROR4>(x); x += dpp<DPP_XOR8>(x); return x; }
__device__ __forceinline__ float half_sum(float x) {
    x = row16_sum(x); auto s_ = __builtin_amdgcn_permlane16_swap(__float_as_uint(x), __float_as_uint(x), false, false); return __uint_as_float(s_[0]) + __uint_as_float(s_[1]); }
__device__ __forceinline__ float wave_sum(float x, int) {
    x = half_sum(x); auto t_ = __builtin_amdgcn_permlane32_swap(__float_as_uint(x), __float_as_uint(x), false, false); return __uint_as_float(t_[0]) + __uint_as_float(t_[1]); }
template <int M> __device__ __forceinline__ float xch(float x, int lane) {
    if constexpr (M == 1) return dpp<DPP_XOR1>(x);
    else if constexpr (M == 2) return dpp<DPP_XOR2>(x);
    else if constexpr (M == 4) return dpp<DPP_XOR3>(dpp<DPP_XOR7>(x));
    else if constexpr (M == 8) return dpp<DPP_XOR8>(x);
    else if constexpr (M == 16) { auto s_ = __builtin_amdgcn_permlane16_swap(__float_as_uint(x), __float_as_uint(x), false, false); return __uint_as_float((lane & 16) ? s_[0] : s_[1]); }
    else { auto s_ = __builtin_amdgcn_permlane32_swap(__float_as_uint(x), __float_as_uint(x), false, false); return __uint_as_float((lane & 32) ? s_[0] : s_[1]); }
}
__device__ __forceinline__ float sigmoidf_(float x) { return __builtin_amdgcn_rcpf(1.f + __builtin_amdgcn_exp2f(-1.4426950408889634f * x)); }
__device__ __forceinline__ float logsigmoidf_(float x) { return fminf(x, 0.f) - __logf(1.f + __expf(-fabsf(x))); }
#define LDS_WAIT() asm volatile("s_waitcnt lgkmcnt(0)" ::: "memory")
#define VM_WAIT() asm volatile("s_waitcnt vmcnt(0)" ::: "memory")

#define XB_TMO      128
#define XB_XCNT(j)  (256  + 64 * (j))
#define XB_XSUB(j)  (1280 + 64 * (j))
#define XB_XGEN(j)  (2304 + 64 * (j))
#define XB_TOP      3328
#define XB_TOPGEN   3392
#define XCD_BAR_WORDS 3456
#define XB_SPIN_CAP (1u << 18)

__device__ __forceinline__ unsigned xb_ld(unsigned* p)              { return __hip_atomic_load(p, __ATOMIC_RELAXED, __HIP_MEMORY_SCOPE_AGENT); }
__device__ __forceinline__ unsigned xb_add(unsigned* p, unsigned v) { return __hip_atomic_fetch_add(p, v, __ATOMIC_RELAXED, __HIP_MEMORY_SCOPE_AGENT); }
__device__ __forceinline__ unsigned xb_xcc_id() { return (unsigned)__builtin_amdgcn_s_getreg((3 << 11) | 20) & 0xFu; }
#define XB_SPIN(cond, bar) do { unsigned _sp = 0; while (cond) { __builtin_amdgcn_s_sleep(1); \
    if ((++_sp & 255u) == 0u) { if (xb_ld(&(bar)[XB_TMO])) break; if (_sp > XB_SPIN_CAP) { atomicAdd(&(bar)[XB_TMO], 1u); break; } } } } while (0)

__device__ __forceinline__ int lane_now() { int l; asm volatile("v_mbcnt_lo_u32_b32 %0, -1, 0\n\tv_mbcnt_hi_u32_b32 %0, -1, %0" : "=v"(l)); return l; }
struct XcdBarrier { unsigned* bar; unsigned x; volatile LAS unsigned* st; int wave; };

__device__ __forceinline__ XcdBarrier xcd_barrier_post(unsigned* bar, volatile LAS unsigned* st, int wave) {
    XcdBarrier b; b.bar = bar; b.x = xb_xcc_id(); b.st = st; b.wave = wave;
    if (wave == 0 && lane_now() == 0) (void)xb_add(&bar[XB_XCNT(b.x)], 1u);
    return b;
}
__device__ __forceinline__ void xcd_barrier_complete(unsigned* bar, unsigned x, unsigned& nloc, unsigned& nx) {
    const unsigned G = gridDim.x * gridDim.y * gridDim.z;
    unsigned sum, cnt, mine, sp = 0u;
    for (;;) {
        sum = 0u; cnt = 0u; mine = 0u;
#pragma unroll
        for (unsigned j = 0; j < 16; ++j) { const unsigned c = xb_ld(&bar[XB_XCNT(j)]); sum += c; cnt += (c > 0u) ? 1u : 0u; mine = (j == x) ? c : mine; }
        if (sum == G) break;
        __builtin_amdgcn_s_sleep(1);
        if ((++sp & 255u) == 0u) { if (xb_ld(&bar[XB_TMO])) break; if (sp > XB_SPIN_CAP) { atomicAdd(&bar[XB_TMO], 1u); break; } }
    }
    nloc = mine > 0u ? mine : 1u; nx = cnt > 0u ? cnt : 1u;
}
__device__ __forceinline__ void xcd_barrier(const XcdBarrier& b) {
    asm volatile("s_waitcnt vmcnt(0)" ::: "memory");
    __syncthreads();
    if (b.wave == 0 && lane_now() == 0) {
        unsigned* bar = b.bar;
        __builtin_amdgcn_s_waitcnt(0);
        unsigned nloc = b.st[0], nx = b.st[1];
        if (nloc == 0u) { xcd_barrier_complete(bar, b.x, nloc, nx); b.st[0] = nloc; b.st[1] = nx; }
        const unsigned old = xb_add(&bar[XB_XSUB(b.x)], 1u);
        const unsigned gen = old / nloc;
        if (old + 1u == (gen + 1u) * nloc) {
            __builtin_amdgcn_fence(__ATOMIC_RELEASE, "agent");
            asm volatile("s_waitcnt vmcnt(0)" ::: "memory");
            const unsigned og = xb_add(&bar[XB_TOP], 1u);
            const unsigned tg = og / nx;
            if (og + 1u == (tg + 1u) * nx) xb_add(&bar[XB_TOPGEN], 1u);
            else XB_SPIN(xb_ld(&bar[XB_TOPGEN]) == tg, bar);
            __builtin_amdgcn_fence(__ATOMIC_ACQUIRE, "agent");
            xb_add(&bar[XB_XGEN(b.x)], 1u);
            asm volatile("s_waitcnt vmcnt(0)" ::: "memory");
        } else {
            XB_SPIN(xb_ld(&bar[XB_XGEN(b.x)]) == gen, bar);
            __builtin_amdgcn_fence(__ATOMIC_ACQUIRE, "agent");
            asm volatile("s_waitcnt vmcnt(0)" ::: "memory");
        }
    }
    __syncthreads();
}

#define CAS __attribute__((address_space(4)))
typedef const float* cfp_t;
struct Args { const float* in[28]; float* out; unsigned char* ws; int ph_lo, ph_hi; };
static_assert(offsetof(Args, in) == 0 && offsetof(Args, out) == 224 && offsetof(Args, ws) == 232 && offsetof(Args, ph_lo) == 240 && sizeof(Args) == 248, "Args layout (the kernel reads the kernarg segment by offset)");
struct Frame {
    LAS unsigned char* lds;
    int tid, lane, wave, G, bid;
    const CAS char* ka; GAS float* out_; GAS unsigned char* ws_;
};
enum { I_X = 0, I_C, I_CTX, I_CCTX, I_N1G, I_N2G, I_MODW, I_MODB, I_MWIN, I_MCONV, I_MGB, I_MNG, I_MWOUT, I_AWIN, I_AQG, I_AKG, I_AWOUT,
       I_GWIN, I_GAW2, I_GAB, I_GNG, I_GWOUT, I_RW, I_RB, I_WGU, I_BGU, I_WD, I_BD };

#define INP(F, k) ((const float*)(((const GAS float* const CAS*)(F).ka)[k]))
#define WSP(F) ((unsigned char*)(F).ws_)
#define OUTP(F) ((float*)(F).out_)
__device__ __forceinline__ Frame refresh(const Frame& F0) {
    Frame L = F0; int t = F0.wave * 64 + lane_now(); asm volatile("" : "+v"(t)); L.tid = t; L.lane = t & 63; L.wave = __builtin_amdgcn_readfirstlane(t >> 6);
    return L;
}

constexpr float Q8_W = 512.f, Q8_U = 4.f, Q8_H = 4.f, Q8_Y = 8.f, Q8_P = 4.f;
__device__ __forceinline__ unsigned pk4_fp8(float a, float b, float c, float d, float S) {
    a = __builtin_amdgcn_fmed3f(a * S, -448.f, 448.f); b = __builtin_amdgcn_fmed3f(b * S, -448.f, 448.f); c = __builtin_amdgcn_fmed3f(c * S, -448.f, 448.f); d = __builtin_amdgcn_fmed3f(d * S, -448.f, 448.f);
    int w = __builtin_amdgcn_cvt_pk_fp8_f32(a, b, 0, false);
    w = __builtin_amdgcn_cvt_pk_fp8_f32(c, d, w, true);
    return (unsigned)w;
}
__device__ __forceinline__ unsigned pk4_fp8_c(float a, float b, float c, float d) {
    a = __builtin_amdgcn_fmed3f(a, -448.f, 448.f); b = __builtin_amdgcn_fmed3f(b, -448.f, 448.f); c = __builtin_amdgcn_fmed3f(c, -448.f, 448.f); d = __builtin_amdgcn_fmed3f(d, -448.f, 448.f);
    int w = __builtin_amdgcn_cvt_pk_fp8_f32(a, b, 0, false); w = __builtin_amdgcn_cvt_pk_fp8_f32(c, d, w, true); return (unsigned)w;
}
namespace g8 {
constexpr int BM = 256, BK = 64, HALF = 128, HTB = HALF * BK * 2, STAGE_BYTES = 8 * HTB, NXCD = 8, WGM = 8;
constexpr int K = 1024;
constexpr unsigned HSTEP = (unsigned)HALF * K * 2;
constexpr size_t TSTEP = 2 * (size_t)HSTEP;

__device__ __forceinline__ int lds_byte(int r, int c) { const int st = (r >> 4) * 2 + (c >> 5), rr = r & 15, cc = c & 31, ob = rr * 64 + cc * 2; return st * 1024 + (ob ^ (((ob >> 9) & 1) << 5)); }
__device__ __forceinline__ void stage_rc(int b, int& R, int& C) { const int st = b / 1024, sb = b % 1024, swz = sb ^ (((sb >> 9) & 1) << 5); R = (st >> 1) * 16 + swz / 64; C = (st & 1) * 32 + (swz % 64) / 2; }
__device__ __forceinline__ int perm32(int rho) { const int n = rho >> 4, i = rho & 15; return 8 * (i >> 2) + 4 * n + (i & 3); }

typedef int i32x4_t __attribute__((ext_vector_type(4)));
typedef int i32x8_t __attribute__((ext_vector_type(8)));
__device__ __forceinline__ i32x8_t cat8(bf16x8 a, bf16x8 b) { const i32x4_t x = __builtin_bit_cast(i32x4_t, a), y = __builtin_bit_cast(i32x4_t, b); return __builtin_shufflevector(x, y, 0, 1, 2, 3, 4, 5, 6, 7); }
struct Unit { const char* a; const char* b0; const char* b1; int orow; int ocol; int e; int aux; };

template <bool F8> struct StaticSched {
    const char* A; const char* Bt; int nM, nN, nwg, G, c, row_off;
    __device__ __forceinline__ void init(const void* A_, const void* Bt_, int M, int N, int G_, int c_, int row_off_ = 0) { A = (const char*)A_ + (size_t)row_off_ * (F8 ? K : K * 2); Bt = (const char*)Bt_; nM = M / BM; nN = N / BM; nwg = nM * nN; G = G_; c = c_; row_off = row_off_; }
    __device__ __forceinline__ bool next(int i, Unit& u) const {
        const long L = (long)i * G + c; if (L >= nwg) return false;
        int wgid = (int)L; { const int q = nwg / NXCD, r = nwg % NXCD, xcd = wgid % NXCD, off = wgid / NXCD; wgid = (xcd < r ? xcd * (q + 1) : r * (q + 1) + (xcd - r) * q) + off; }
        const int nig = WGM * nN, gid = wgid / nig, fm = gid * WGM, gsz = (nM - fm) < WGM ? (nM - fm) : WGM;
        const int pm = fm + ((wgid % nig) % gsz), pn = (wgid % nig) / gsz;
        u.a = A + (size_t)pm * (F8 ? TSTEP / 2 : TSTEP); u.b0 = Bt + (size_t)pn * (F8 ? TSTEP / 2 : TSTEP); u.b1 = u.b0 + (F8 ? HSTEP / 2 : HSTEP); u.orow = row_off + pm * BM; u.ocol = pn * BM; u.e = 0; u.aux = 0; return true;
    }
    static constexpr bool GATHER = false, FP8 = F8;
    __device__ __forceinline__ int zero() const { return nwg >> 30; }
    __device__ __forceinline__ void a_rows(const Unit&, const unsigned (&)[2], unsigned (&)[2], __amdgpu_buffer_rsrc_t, const char*) const {}
};
template <bool GU> struct MoeSched {
    const char* A; const char* W; const int* slottok; const LAS int* tab; int nunits, G, c;
    static constexpr int NPN = GU ? 8 : 4;
    __device__ __forceinline__ bool next(int i, Unit& u) const {
        constexpr int TL = 32 / NPN;
        const int x = c & 7, j = c >> 3, ntl = nunits / NPN, ngr = (ntl + TL - 1) / TL, g = ((x * ngr) >> 3) + i;
        if (g >= (((x + 1) * ngr) >> 3)) return false;
        const int T = g * TL + j / NPN, pn = j % NPN;
        if (T >= ntl) return false;
        const int e = __builtin_amdgcn_readfirstlane(tab[80 + T]);
        u.e = e; u.orow = T * BM; u.ocol = pn; u.aux = (T - __builtin_amdgcn_readfirstlane(tab[32 + e])) * BM;
        if (GU) { u.a = A; u.b0 = W + (size_t)e * (2048u * 1024u) + (size_t)pn * (HSTEP / 2); u.b1 = u.b0 + (size_t)1024 * 1024; }
        else { u.a = A + (size_t)T * (TSTEP / 2); u.b0 = W + (size_t)e * (1024u * 1024u) + (size_t)pn * (TSTEP / 2); u.b1 = u.b0 + HSTEP / 2; }
        return true;
    }
    __device__ __forceinline__ int zero() const { return nunits >> 30; }
    static constexpr bool GATHER = GU, FP8 = true;
    __device__ __forceinline__ void a_rows(const Unit& u, const unsigned (&sv)[2], unsigned (&tk)[2], __amdgpu_buffer_rsrc_t rs, const char* wsb) const {
        const int cnt = __builtin_amdgcn_readfirstlane(tab[u.e]);
        const int sbase = (int)(unsigned)((const char*)(slottok + u.e * NTOK) - wsb);
        unsigned a0 = sv[0], a1 = sv[1]; asm volatile("" : "+v"(a0), "+v"(a1));
        const int r0 = (int)(a0 >> 10), r1 = (int)(a1 >> 10);
#pragma unroll
        for (int h = 0; h < 2; ++h) {
            const int s0 = u.aux + h * HALF + r0, s1 = u.aux + h * HALF + r1;
            const int l0 = __builtin_amdgcn_raw_buffer_load_b32(rs, s0 * 4, sbase, 0), l1 = __builtin_amdgcn_raw_buffer_load_b32(rs, s1 * 4, sbase, 0);
            const int t0 = (s0 < cnt) ? l0 : 0, t1 = (s1 < cnt) ? l1 : 0;
            tk[h] = (unsigned)t0 | ((unsigned)t1 << 16);
        }
    }
};

struct EpiBf16 {
    static constexpr bool PERM = true, PRE = false;
    bf16_t* O; int ldc;
    __device__ __forceinline__ void operator()(const f32x4 (&acc)[2][2][4][2], const Unit& u, int wr, int wc, int fr, int fq) const {
        const int row0 = u.orow + wr * 64 + fr, col0 = u.ocol + wc * 32 + 8 * fq;
#pragma unroll
        for (int ai = 0; ai < 2; ++ai)
#pragma unroll
            for (int m = 0; m < 4; ++m) { bf16_t* rowp = O + (size_t)(row0 + ai * HALF + m * 16) * ldc + col0;
#pragma unroll
                for (int bj = 0; bj < 2; ++bj) { const f32x4 v0 = acc[ai][bj][m][0], v1 = acc[ai][bj][m][1];
                    u32x4 w; w.x = cvt_pk_bf16(v0[0], v0[1]); w.y = cvt_pk_bf16(v0[2], v0[3]); w.z = cvt_pk_bf16(v1[0], v1[1]); w.w = cvt_pk_bf16(v1[2], v1[3]);
                    *(u32x4*)(rowp + bj * HALF) = w; } }
    }
};
struct EpiDelta {
    static constexpr bool PERM = true, PRE = true;
    bf16_t* O; const float* mod2;
    __device__ __forceinline__ void prefetch(const Unit& u, LAS unsigned char* aux, int lane) const {
        const int r = u.orow < NCTXR ? 4 : ((u.orow - NCTXR) >> 12);
        __builtin_amdgcn_global_load_lds((const unsigned*)(mod2 + r * 6144 + u.ocol + lane * 4), (LAS unsigned*)aux, 16, 0, 0);
    }
    __device__ __forceinline__ void operator()(const f32x4 (&acc)[2][2][4][2], const Unit& u, int wr, int wc, int fr, int fq, const LAS unsigned char* aux) const {
        const int row0 = u.orow + wr * 64 + fr, cu = wc * 32 + 8 * fq, col0 = u.ocol + cu;
        f32x4 mv[2][2];
#pragma unroll
        for (int bj = 0; bj < 2; ++bj)
#pragma unroll
            for (int n = 0; n < 2; ++n) mv[bj][n] = *(const LAS f32x4*)(aux + (bj * HALF + cu + 4 * n) * 4) * (1.f / (Q8_P * Q8_W));
#pragma unroll
        for (int ai = 0; ai < 2; ++ai)
#pragma unroll
            for (int m = 0; m < 4; ++m) { bf16_t* rowp = O + (size_t)(row0 + ai * HALF + m * 16) * DM + col0;
#pragma unroll
                for (int bj = 0; bj < 2; ++bj) { const f32x4 v0 = acc[ai][bj][m][0] * mv[bj][0], v1 = acc[ai][bj][m][1] * mv[bj][1];
                    u32x4 w; w.x = cvt_pk_bf16(v0[0], v0[1]); w.y = cvt_pk_bf16(v0[2], v0[3]); w.z = cvt_pk_bf16(v1[0], v1[1]); w.w = cvt_pk_bf16(v1[2], v1[3]);
                    *(u32x4*)(rowp + bj * HALF) = w; } }
    }
};
struct EpiSwiglu {
    static constexpr bool PERM = true, PRE = true;
    unsigned char* H; const float* bgu;
    __device__ __forceinline__ void prefetch(const Unit& u, LAS unsigned char* aux, int lane) const {
        const float* g = bgu + u.e * 2048 + u.ocol * 128 + (lane >> 5) * 1024 + (lane & 31) * 4;
        __builtin_amdgcn_global_load_lds((const unsigned*)g, (LAS unsigned*)aux, 16, 0, 0);
    }
    __device__ __forceinline__ void operator()(const f32x4 (&acc)[2][2][4][2], const Unit& u, int wr, int wc, int fr, int fq, const LAS unsigned char* aux) const {
        const int row0 = u.orow + wr * 64 + fr, cl = wc * 32 + 8 * fq, col0 = u.ocol * 128 + cl;
        f32x4 bg[2], bl[2];
#pragma unroll
        for (int n = 0; n < 2; ++n) { bg[n] = *(const LAS f32x4*)(aux + (cl + 4 * n) * 4); bl[n] = *(const LAS f32x4*)(aux + 512 + (cl + 4 * n) * 4); }
#pragma unroll
        for (int ai = 0; ai < 2; ++ai)
#pragma unroll
            for (int m = 0; m < 4; ++m) {
                f32x2 o2[4];
#pragma unroll
                for (int n = 0; n < 2; ++n) { const f32x4 gv = acc[ai][0][m][n] * (1.f / (Q8_U * Q8_W)) + bg[n], lv = acc[ai][1][m][n] * (1.f / (Q8_U * Q8_W)) + bl[n];
#pragma unroll
                    for (int p = 0; p < 2; ++p) {
                        const f32x2 g = (f32x2){fminf(gv[2 * p], 7.f), fminf(gv[2 * p + 1], 7.f)};
                        const f32x2 li = (f32x2){__builtin_amdgcn_fmed3f(lv[2 * p], -7.f, 7.f), __builtin_amdgcn_fmed3f(lv[2 * p + 1], -7.f, 7.f)};
                        const f32x2 t = (f32x2){fmaxf(g.x, -20.f), fmaxf(g.y, -20.f)} * -2.4554669595930156f;
                        const f32x2 d = (f32x2){__builtin_amdgcn_exp2f(t.x), __builtin_amdgcn_exp2f(t.y)} + 1.f;
                        const float r = __builtin_amdgcn_rcpf(d.x * d.y);
                        const f32x2 sg = (f32x2){d.y, d.x} * r;
                        o2[n * 2 + p] = g * (li * Q8_H + Q8_H) * sg; } }
                u32x2 w;
                { int w0 = __builtin_amdgcn_cvt_pk_fp8_f32(o2[0].x, o2[0].y, 0, false); w0 = __builtin_amdgcn_cvt_pk_fp8_f32(o2[1].x, o2[1].y, w0, true);
                  int w1 = __builtin_amdgcn_cvt_pk_fp8_f32(o2[2].x, o2[2].y, 0, false); w1 = __builtin_amdgcn_cvt_pk_fp8_f32(o2[3].x, o2[3].y, w1, true); w.x = (unsigned)w0; w.y = (unsigned)w1; }
                *(u32x2*)(H + (size_t)(row0 + ai * HALF + m * 16) * DM + col0) = w; }
    }
};
struct EpiDown {
    static constexpr bool PERM = true, PRE = true;
    unsigned char* Y; const float* bd;
    __device__ __forceinline__ void prefetch(const Unit& u, LAS unsigned char* aux, int lane) const {
        __builtin_amdgcn_global_load_lds((const unsigned*)(bd + u.e * 1024 + u.ocol * 256 + lane * 4), (LAS unsigned*)aux, 16, 0, 0);
    }
    __device__ __forceinline__ void operator()(const f32x4 (&acc)[2][2][4][2], const Unit& u, int wr, int wc, int fr, int fq, const LAS unsigned char* aux) const {
        const int row0 = u.orow + wr * 64 + fr, cu = wc * 32 + 8 * fq, col0 = u.ocol * 256 + cu;
        f32x4 bv[2][2];
#pragma unroll
        for (int bj = 0; bj < 2; ++bj)
#pragma unroll
            for (int n = 0; n < 2; ++n) bv[bj][n] = *(const LAS f32x4*)(aux + (bj * HALF + cu + 4 * n) * 4) * Q8_Y;
#pragma unroll
        for (int ai = 0; ai < 2; ++ai)
#pragma unroll
            for (int m = 0; m < 4; ++m) { unsigned char* rowp = Y + (size_t)(row0 + ai * HALF + m * 16) * DM + col0;
#pragma unroll
                for (int bj = 0; bj < 2; ++bj) { const f32x4 v0 = acc[ai][bj][m][0] * (Q8_Y / (Q8_H * Q8_W)) + bv[bj][0], v1 = acc[ai][bj][m][1] * (Q8_Y / (Q8_H * Q8_W)) + bv[bj][1];
                    u32x2 w; w.x = pk4_fp8_c(v0[0], v0[1], v0[2], v0[3]); w.y = pk4_fp8_c(v1[0], v1[1], v1[2], v1[3]);
                    *(u32x2*)(rowp + bj * HALF) = w; } }
    }
};

template <class Epi, class Sched>
__device__ __forceinline__ void gemm_phase(LAS unsigned char* lds, const Sched& S, const Epi& E, const char* wsb, int wv) {
    const __amdgpu_buffer_rsrc_t rs = __builtin_amdgcn_make_buffer_rsrc((void*)wsb, 0, 0x7fffffff, 0x00020000);
    int tz = wv * 64 + lane_now(); asm volatile("" : "+v"(tz));
    const int tid = tz, wid = __builtin_amdgcn_readfirstlane(tid >> 6), lane = tid & 63, wr = wid >> 2, wc = wid & 3, fr = lane & 15, fq = lane >> 4;
    constexpr bool FP8 = Sched::FP8;
    constexpr int RS = FP8 ? 1024 : 2048;
    constexpr unsigned HS = 128u * RS;
    const int nt = (FP8 ? 8 : K / BK) + S.zero();
    constexpr bool GATHER = Sched::GATHER;
    unsigned svA[2], voffB[2];
#pragma unroll
    for (int i = 0; i < 2; ++i) { int R, C; stage_rc(tid * 16 + i * 8192, R, C); const int Rb = Epi::PERM ? ((R & ~31) + perm32(R & 31)) : R;
        svA[i] = (unsigned)(R * RS + C * 2); voffB[i] = (unsigned)(Rb * RS + C * 2); }
    constexpr size_t kstep = (size_t)(BK * 2);
    const unsigned ldsw = (unsigned)wid * 1024u;
    const int aoff = lds_byte(wr * 64 + fr, fq * 8), boff = lds_byte(wc * 32 + fr, fq * 8);
#define G8_SA(b, h) (((b) * 2 + (h)) * HTB)
#define G8_SB(b, h) ((4 + (b) * 2 + (h)) * HTB)
#define G8_STAGE2(bufoff, gbase, v0, v1) do { const int _so = (int)(unsigned)((const char*)(gbase) - wsb); \
        __builtin_amdgcn_raw_ptr_buffer_load_lds(rs, (LAS unsigned*)(lds + (bufoff) + ldsw), 16, (int)(v0), _so, 0, 0); \
        __builtin_amdgcn_raw_ptr_buffer_load_lds(rs, (LAS unsigned*)(lds + (bufoff) + ldsw + 8192), 16, (int)(v1), _so, 0, 0); } while (0)
#define G8_STAGE_A(bufoff, gbase, h, tk) do { if constexpr (GATHER) { const unsigned _t = (tk)[h]; \
            G8_STAGE2(bufoff, gbase, (_t & 0xffffu) * (unsigned)RS + (svA[0] & (unsigned)(RS - 1)), (_t >> 16) * (unsigned)RS + (svA[1] & (unsigned)(RS - 1))); } \
        else { G8_STAGE2(bufoff, (gbase) + (h) * HS, svA[0], svA[1]); } } while (0)
#define G8_LDA(dst, b, h) do { _Pragma("unroll") for (int m = 0; m < 4; ++m) _Pragma("unroll") for (int k = 0; k < 2; ++k) dst[m][k] = *(const LAS bf16x8*)(lds + G8_SA(b, h) + aoff + m * 2048 + k * 1024); } while (0)
#define G8_LDB(dst, b, h) do { _Pragma("unroll") for (int n = 0; n < 2; ++n) _Pragma("unroll") for (int k = 0; k < 2; ++k) dst[n][k] = *(const LAS bf16x8*)(lds + G8_SB(b, h) + boff + n * 2048 + k * 1024); } while (0)
#define G8_MMA(ai, bj, At, Bt) do { __builtin_amdgcn_s_setprio(1); _Pragma("unroll") for (int m = 0; m < 4; ++m) _Pragma("unroll") for (int n = 0; n < 2; ++n) { \
        if constexpr (FP8) acc[ai][bj][m][n] = __builtin_amdgcn_mfma_scale_f32_16x16x128_f8f6f4(cat8(Bt[n][0], Bt[n][1]), cat8(At[m][0], At[m][1]), acc[ai][bj][m][n], 0, 0, 0, 0, 0, 0); \
        else { _Pragma("unroll") for (int k = 0; k < 2; ++k) acc[ai][bj][m][n] = __builtin_amdgcn_mfma_f32_16x16x32_bf16(Bt[n][k], At[m][k], acc[ai][bj][m][n], 0, 0, 0); } } \
        __builtin_amdgcn_s_setprio(0); } while (0)
#define G8_WAIT_V(n) asm volatile("s_waitcnt vmcnt(" #n ")" ::: "memory")
#define G8_WAIT_L(n) asm volatile("s_waitcnt lgkmcnt(" #n ")" ::: "memory")
#define G8_BAR __builtin_amdgcn_s_barrier()
#define G8_SCHED __builtin_amdgcn_sched_barrier(0)
    Unit cur, nxt; int ui = 0;
    if (!S.next(0, cur)) return;
    LAS unsigned char* const auxb = lds + (TAB_OFF + 2048);
    if constexpr (Epi::PRE) { if (wid == 0) E.prefetch(cur, auxb, lane_now()); }
    unsigned ctk[2] = {0u, 0u}, ntk[2] = {0u, 0u};
    if constexpr (GATHER) S.a_rows(cur, svA, ctk, rs, wsb);
    f32x4 acc[2][2][4][2];
#pragma unroll
    for (int a = 0; a < 2; ++a)
#pragma unroll
        for (int b = 0; b < 2; ++b)
#pragma unroll
            for (int m = 0; m < 4; ++m)
#pragma unroll
                for (int n = 0; n < 2; ++n) acc[a][b][m][n] = (f32x4){0.f, 0.f, 0.f, 0.f};
    bf16x8 At[4][2], B0[2][2], B1[2][2];
    const char* cA = cur.a; const char* cB0 = cur.b0; const char* cB1 = cur.b1;
    G8_STAGE2(G8_SB(0, 0), cB0, voffB[0], voffB[1]); G8_STAGE_A(G8_SA(0, 0), cA, 0, ctk); G8_STAGE2(G8_SB(0, 1), cB1, voffB[0], voffB[1]); G8_STAGE_A(G8_SA(0, 1), cA, 1, ctk);
    if (wr == 1) G8_BAR;
    G8_WAIT_V(4); G8_BAR;
    G8_STAGE2(G8_SB(1, 0), cB0 + kstep, voffB[0], voffB[1]); G8_STAGE_A(G8_SA(1, 0), cA + kstep, 0, ctk); G8_STAGE2(G8_SB(1, 1), cB1 + kstep, voffB[0], voffB[1]);
    G8_WAIT_V(6); G8_BAR;
    for (;;) {
        const bool has_next = S.next(ui + 1, nxt);
        const char* nA = has_next ? nxt.a : cA; const char* nB0 = has_next ? nxt.b0 : cB0; const char* nB1 = has_next ? nxt.b1 : cB1;
        ntk[0] = ctk[0]; ntk[1] = ctk[1];
#pragma nounroll
        for (int t = 0; t < nt; t += 2) {
            const bool last = (t == nt - 2);
            if constexpr (GATHER) { if (t == nt - 4 && has_next) S.a_rows(nxt, svA, ntk, rs, wsb); }
            const char* a1 = cA + (size_t)(t + 1) * kstep;
            const char* a2 = last ? nA : cA + (size_t)(t + 2) * kstep;
            const char* b20 = last ? nB0 : cB0 + (size_t)(t + 2) * kstep; const char* b21 = last ? nB1 : cB1 + (size_t)(t + 2) * kstep;
            const char* a3 = a2 + kstep; const char* b30 = b20 + kstep; const char* b31 = b21 + kstep;
            G8_LDB(B0, 0, 0); G8_SCHED; G8_LDA(At, 0, 0); G8_STAGE_A(G8_SA(1, 1), a1, 1, ctk);
            if constexpr (GATHER) { if (last) { ctk[0] = ntk[0]; ctk[1] = ntk[1]; } }
            G8_WAIT_L(8); G8_BAR; G8_WAIT_L(0); G8_MMA(0, 0, At, B0); G8_BAR; G8_SCHED;
            G8_LDB(B1, 0, 1); G8_STAGE2(G8_SB(0, 0), b20, voffB[0], voffB[1]);
            G8_BAR; G8_WAIT_L(0); G8_MMA(0, 1, At, B1); G8_BAR;
            G8_LDA(At, 0, 1); G8_STAGE_A(G8_SA(0, 0), a2, 0, ctk);
            G8_BAR; G8_WAIT_L(0); G8_MMA(1, 0, At, B0); G8_BAR; G8_SCHED;
            G8_STAGE2(G8_SB(0, 1), b21, voffB[0], voffB[1]);
            G8_WAIT_V(6); G8_BAR; G8_MMA(1, 1, At, B1); G8_BAR;
            G8_LDB(B0, 1, 0); G8_SCHED; G8_LDA(At, 1, 0); G8_STAGE_A(G8_SA(0, 1), a2, 1, ctk);
            G8_WAIT_L(8); G8_BAR; G8_WAIT_L(0); G8_MMA(0, 0, At, B0); G8_BAR; G8_SCHED;
            G8_LDB(B1, 1, 1); G8_STAGE2(G8_SB(1, 0), b30, voffB[0], voffB[1]);
            G8_BAR; G8_WAIT_L(0); G8_MMA(0, 1, At, B1); G8_BAR;
            G8_LDA(At, 1, 1); G8_STAGE_A(G8_SA(1, 0), a3, 0, ctk);
            G8_BAR; G8_WAIT_L(0); G8_MMA(1, 0, At, B0); G8_BAR; G8_SCHED;
            G8_STAGE2(G8_SB(1, 1), b31, voffB[0], voffB[1]);
            G8_WAIT_V(6); G8_BAR; G8_MMA(1, 1, At, B1); G8_BAR;
        }
        { int t2 = lane_now(); asm volatile("" : "+v"(t2)); const int l2 = t2 & 63;
          if constexpr (Epi::PRE) E(acc, cur, wr, wc, l2 & 15, l2 >> 4, auxb + (ui & 1) * 1024); else E(acc, cur, wr, wc, l2 & 15, l2 >> 4); }
        if (!has_next) break;
#pragma unroll
        for (int a = 0; a < 2; ++a)
#pragma unroll
            for (int b = 0; b < 2; ++b)
#pragma unroll
                for (int m = 0; m < 4; ++m)
#pragma unroll
                    for (int n = 0; n < 2; ++n) acc[a][b][m][n] = (f32x4){0.f, 0.f, 0.f, 0.f};
        cur = nxt; cA = nA; cB0 = nB0; cB1 = nB1; ++ui;
        if constexpr (Epi::PRE) { if (wid == 0) E.prefetch(cur, auxb + (ui & 1) * 1024, lane_now()); }
    }
    G8_WAIT_V(0);
    if (wr == 0) G8_BAR;
    G8_BAR;
#undef G8_SA
#undef G8_SB
#undef G8_STAGE2
#undef G8_STAGE_A
#undef G8_LDA
#undef G8_LDB
#undef G8_MMA
#undef G8_WAIT_V
#undef G8_WAIT_L
#undef G8_BAR
#undef G8_SCHED
}
}

template <bool F8> __device__ __forceinline__ void tc_item(const float* W, int N, int Nvalid, bf16_t* WT, int k0, int n0, LAS float* scr, int lane) {
    const bool ok = (n0 + lane) < Nvalid;
    const float* src = W + (size_t)k0 * N + n0 + lane;
#pragma unroll 16
    for (int i = 0; i < 64; ++i) { const float v = ok ? src[(size_t)i * N] : 0.f; scr[i * 65 + lane] = v; }
    LDS_WAIT();
    const int c = lane & 7, nr = lane >> 3;
#pragma unroll
    for (int j = 0; j < 8; ++j) { const int n = nr + 8 * j; const LAS float* s = scr + (8 * c) * 65 + n;
        if constexpr (F8) { u32x2 o; o.x = pk4_fp8(s[0], s[65], s[2 * 65], s[3 * 65], Q8_W); o.y = pk4_fp8(s[4 * 65], s[5 * 65], s[6 * 65], s[7 * 65], Q8_W);
            *(u32x2*)((unsigned char*)WT + (size_t)(n0 + n) * 1024 + k0 + 8 * c) = o; }
        else { u32x4 o; o.x = cvt_pk_bf16(s[0], s[65]); o.y = cvt_pk_bf16(s[2 * 65], s[3 * 65]); o.z = cvt_pk_bf16(s[4 * 65], s[5 * 65]); o.w = cvt_pk_bf16(s[6 * 65], s[7 * 65]);
            *(u32x4*)(WT + (size_t)(n0 + n) * 1024 + k0 + 8 * c) = o; } }
    LDS_WAIT();
}
struct ConvTile { const float* src; unsigned char* dst; int N; };
__device__ __forceinline__ void conv_load(const ConvTile& T, f32x4 (&r)[16], int lane) {
    const int kq = lane >> 4, nq = lane & 15;
    const float* p = T.src + (size_t)kq * T.N + nq * 4;
#pragma unroll
    for (int i = 0; i < 16; ++i) r[i] = __builtin_nontemporal_load((const f32x4*)(p + (size_t)(4 * i) * T.N));
}
__device__ __forceinline__ void conv_emit(const ConvTile& T, const f32x4 (&r)[16], LAS float* scr, int lane) {
    const int kq = lane >> 4, nq = lane & 15;
#pragma unroll
    for (int i = 0; i < 16; ++i) { LAS float* w = scr + (4 * i + kq) * 65 + nq * 4; w[0] = r[i].x; w[1] = r[i].y; w[2] = r[i].z; w[3] = r[i].w; }
    LDS_WAIT();
    const int c = lane & 7, nr = lane >> 3;
#pragma unroll
    for (int j = 0; j < 8; ++j) { const int n = nr + 8 * j; const LAS float* s = scr + (8 * c) * 65 + n;
        u32x2 o; o.x = pk4_fp8(s[0], s[65], s[2 * 65], s[3 * 65], Q8_W); o.y = pk4_fp8(s[4 * 65], s[5 * 65], s[6 * 65], s[7 * 65], Q8_W);
        __builtin_nontemporal_store(o, (u32x2*)(T.dst + (size_t)n * 1024 + 8 * c)); }
    LDS_WAIT();
}
__device__ __forceinline__ bool moe_conv_tile(const Frame& F, int l0, int it, int nitems, ConvTile& T) {
    if (it >= nitems) return false;
    const int l = l0 + it / 24576, r = it % 24576;
    if (r < 16384) { const int mi = l * 32 + (r >> 9), j = r & 511, kb = j >> 5, nb = j & 31;
        T.src = INP(F, I_WGU) + (size_t)mi * 1024 * 2048 + (size_t)(kb * 64) * 2048 + nb * 64; T.dst = WSP(F) + WS_WGU + (size_t)mi * 2048 * 1024 + (size_t)(nb * 64) * 1024 + kb * 64; T.N = 2048; }
    else { const int q = r - 16384, mi = l * 32 + (q >> 8), j = q & 255, kb = j >> 4, nb = j & 15;
        T.src = INP(F, I_WD) + (size_t)mi * 1024 * 1024 + (size_t)(kb * 64) * 1024 + nb * 64; T.dst = WSP(F) + WS_WD + (size_t)mi * 1024 * 1024 + (size_t)(nb * 64) * 1024 + kb * 64; T.N = 1024; }
    return true;
}
__device__ __forceinline__ void moe_convert(const Frame& F, int l0, int l1, int w, int nw) {
    LAS float* scr = (LAS float*)(F.lds + F.wave * 16640);
    const int nitems = (l1 - l0) * 24576;
    ConvTile Ta, Tb; f32x4 ra[16], rb[16];
    int it = w;
    bool va = moe_conv_tile(F, l0, it, nitems, Ta);
    if (va) conv_load(Ta, ra, F.lane);
    while (va) {
        const bool vb = moe_conv_tile(F, l0, it + nw, nitems, Tb);
        if (vb) conv_load(Tb, rb, F.lane);
        conv_emit(Ta, ra, scr, F.lane);
        if (!vb) break;
        it += 2 * nw;
        va = moe_conv_tile(F, l0, it, nitems, Ta);
        if (va) conv_load(Ta, ra, F.lane);
        conv_emit(Tb, rb, scr, F.lane);
    }
}
__device__ __forceinline__ void phase_p0(const Frame& F0) {
    Frame F = refresh(F0);
    {
        LAS float* cond = (LAS float*)F.lds; LAS float* red = cond + 5 * 1024;
        for (int i = F.tid; i < 5 * 1024; i += 512) { const int r = i >> 10, k = i & 1023; const float c = r < 4 ? INP(F, I_C)[r * 1024 + k] : INP(F, I_CCTX)[k]; cond[i] = c / (1.f + __expf(-c)); }
        __syncthreads();
        float* modv = (float*)(WSP(F) + WS_MODV);
        for (int it = F.bid; it < 384; it += F.G) {
            const int l = it / 96, n0 = (it % 96) * 64, k0 = F.wave * 128;
            const float* W = INP(F, I_MODW) + (size_t)l * 1024 * 6144 + (size_t)k0 * 6144 + n0 + F.lane;
            float a0 = 0.f, a1 = 0.f, a2 = 0.f, a3 = 0.f, a4 = 0.f;
#pragma unroll 8
            for (int k = 0; k < 128; ++k) { const float w = W[(size_t)k * 6144]; const LAS float* cp = cond + k0 + k;
                a0 += cp[0] * w; a1 += cp[1024] * w; a2 += cp[2048] * w; a3 += cp[3072] * w; a4 += cp[4096] * w; }
            LAS float* rp = red + F.wave * 320 + F.lane;
            rp[0] = a0; rp[64] = a1; rp[128] = a2; rp[192] = a3; rp[256] = a4;
            __syncthreads();
            if (F.tid < 320) { const int r = F.tid >> 6, ln = F.tid & 63; float s = 0.f;
#pragma unroll
                for (int w = 0; w < 8; ++w) s += red[w * 320 + r * 64 + ln];
                modv[(size_t)(l * 5 + r) * 6144 + n0 + ln] = s + INP(F, I_MODB)[l * 6144 + n0 + ln]; }
            __syncthreads();
        }
        __syncthreads();
    }
    {
        u32x4* rwf = (u32x4*)(WSP(F) + WS_ROUTW);
        for (int idx = F.bid * 512 + F.tid; idx < 4 * 8 * 4 * 2 * 64; idx += F.G * 512) {
            const int ln = idx & 63, n = (idx >> 6) & 1, kk = (idx >> 7) & 3, w = (idx >> 9) & 7, l = idx >> 12;
            const int k0 = (w * 4 + kk) * 32 + (ln >> 4) * 8, e = n * 16 + (ln & 15);
            const float* src = INP(F, I_RW) + ((size_t)l * 1024 + k0) * 32 + e;
            float x[8], lo[8];
#pragma unroll
            for (int i = 0; i < 8; ++i) { x[i] = src[i * 32]; lo[i] = x[i] - bf2f(f2bf(x[i])); }
            u32x4 h, o; h.x = cvt_pk_bf16(x[0], x[1]); h.y = cvt_pk_bf16(x[2], x[3]); h.z = cvt_pk_bf16(x[4], x[5]); h.w = cvt_pk_bf16(x[6], x[7]);
            o.x = cvt_pk_bf16(lo[0], lo[1]); o.y = cvt_pk_bf16(lo[2], lo[3]); o.z = cvt_pk_bf16(lo[4], lo[5]); o.w = cvt_pk_bf16(lo[6], lo[7]);
            rwf[(size_t)(idx >> 6) * 128 + ln] = h; rwf[(size_t)(idx >> 6) * 128 + 64 + ln] = o;
        }
    }
    {
        LAS float* scr = (LAS float*)(F.lds + F.wave * 16640);
        const int gw = F.bid * 8 + F.wave, NGW = F.G * 8;
        constexpr int I_A = 16 * 52, I_B = 16 * 32, I_O = 16 * 16, I_GU = 16 * 32, I_DN = 16 * 16;
        constexpr int E0 = I_A, E1 = 2 * I_A, E2 = E1 + I_B, E3 = E2 + I_A, E4 = E3 + 4 * I_O, E5 = E4 + 128 * I_GU, E6 = E5 + 128 * I_DN;
        bf16_t* win = (bf16_t*)(WSP(F) + WS_WIN);
        for (int it = gw; it < E4; it += NGW) {
            const float* W; bf16_t* WT; int N, Nv, nbn, j;
            if (it < E1) { const int q = it >= E0; j = it - q * I_A; W = INP(F, I_MWIN) + (size_t)q * 1024 * 3104; WT = win + (size_t)(q ? 3 : 0) * (7 * MiB / 2); N = 3104; Nv = 3104; nbn = 52; }
            else if (it < E2) { j = it - E1; W = INP(F, I_AWIN); WT = win + (size_t)1 * (7 * MiB / 2); N = 2048; Nv = 2048; nbn = 32; }
            else if (it < E3) { j = it - E2; W = INP(F, I_GWIN); WT = win + (size_t)2 * (7 * MiB / 2); N = 3104; Nv = 3104; nbn = 52; }
            else if (it < E4) { const int q = (it - E3) >> 8; j = (it - E3) & 255; N = 1024; Nv = 1024; nbn = 16;
                W = q == 0 ? INP(F, I_MWOUT) : q == 1 ? INP(F, I_AWOUT) : q == 2 ? INP(F, I_GWOUT) : INP(F, I_MWOUT) + (size_t)1024 * 1024;
                WT = (bf16_t*)(WSP(F) + WS_WOUT + (size_t)q * 1024 * 1024); }
            else if (it < E5) { const int mi = (it - E4) >> 9; j = (it - E4) & 511; N = 2048; Nv = 2048; nbn = 32;
                W = INP(F, I_WGU) + (size_t)mi * 1024 * 2048; WT = (bf16_t*)(WSP(F) + WS_WGU) + (size_t)mi * 2048 * 1024; }
            else { const int mi = (it - E5) >> 8; j = (it - E5) & 255; N = 1024; Nv = 1024; nbn = 16;
                W = INP(F, I_WD) + (size_t)mi * 1024 * 1024; WT = (bf16_t*)(WSP(F) + WS_WD) + (size_t)mi * 1024 * 1024; }
            const int kb = j / nbn, nb = j % nbn;
            if (it >= E3) tc_item<true>(W, N, Nv, WT, kb * 64, nb * 64, scr, F.lane); else tc_item<false>(W, N, Nv, WT, kb * 64, nb * 64, scr, F.lane);
        }
    }
}

__device__ __forceinline__ void moe_tstart_table(const Frame& F0, int l) {
    Frame F = refresh(F0);
    LAS int* tab = (LAS int*)(F.lds + TAB_OFF);
    if (F.tid < 64) {
        const unsigned* cnt = (const unsigned*)(WSP(F) + WS_CTL) + CW_CNT + l * 32;
        const int e = F.lane & 31;
        const int c = (int)__hip_atomic_load(cnt + e, __ATOMIC_RELAXED, __HIP_MEMORY_SCOPE_AGENT);
        const int nt = (c + 255) >> 8;
        int inc = nt;
#pragma unroll
        for (int d = 1; d < 32; d <<= 1) { const int t_ = __builtin_amdgcn_ds_bpermute((((F.lane & 31) >= d ? F.lane - d : F.lane)) << 2, inc); if ((F.lane & 31) >= d) inc += t_; }
        const int start = inc - nt;
        if (F.lane < 32) { tab[e] = c; tab[32 + e] = start; if (e == 31) tab[64] = inc;
#pragma nounroll
            for (int t = 0; t < nt; ++t) tab[80 + start + t] = e; }
    }
    __syncthreads();
}
__device__ __forceinline__ void phase_a(const Frame& F0, int l) {
    Frame F = refresh(F0);
    const LAS int* tab = (const LAS int*)(F.lds + TAB_OFF);
#if MK_MULTI
    if (l > 0) moe_tstart_table(F, l - 1);
#endif
    const int gw = F.bid * 8 + F.wave, NGW = F.G * 8;
    const float* modv = (const float*)(WSP(F) + WS_MODV);
    const unsigned char* Y2 = WSP(F) + WS_Y2;
    const int2* tokrec = (const int2*)(WSP(F) + WS_TOKREC);
    float* hctx = (float*)(WSP(F) + WS_HCTX);
    bf16_t* HB = (bf16_t*)(WSP(F) + WS_HB);
    bf16_t* U = (bf16_t*)(WSP(F) + WS_U);
    constexpr int NR = 2;
    for (int row0 = (l == 4 ? NCTXR : 0) + gw; row0 < NTOK; row0 += NR * NGW) {
        int row[NR]; bool ok[NR]; int rr[NR]; float* hp[NR]; f32x4 v[NR][4]; int2 rc[NR][4];
#pragma unroll
        for (int q = 0; q < NR; ++q) { row[q] = row0 + q * NGW; ok[q] = row[q] < NTOK; if (!ok[q]) row[q] = row0;
            const bool isctx = row[q] < NCTXR; rr[q] = isctx ? 4 : ((row[q] - NCTXR) >> 12);
            hp[q] = isctx ? hctx + (size_t)row[q] * DM : OUTP(F) + (size_t)(row[q] - NCTXR) * DM;
            if (l == 0) { const float* src = isctx ? INP(F, I_CTX) + (size_t)row[q] * DM : INP(F, I_X) + (size_t)(row[q] - NCTXR) * DM;
#pragma unroll
                for (int j = 0; j < 4; ++j) v[q][j] = *((const f32x4*)src + F.lane + 64 * j); }
            else {
#pragma unroll
                for (int j = 0; j < 4; ++j) { const u32x2 hw = *((const u32x2*)(HB + (size_t)row[q] * DM) + F.lane + 64 * j); v[q][j] = (f32x4){bflo(hw.x), bfhi(hw.x), bflo(hw.y), bfhi(hw.y)}; } }
            if (l > 0) {
#pragma unroll
                for (int k = 0; k < 4; ++k) rc[q][k] = tokrec[row[q] * 4 + k]; } }
        if (l > 0) {
            unsigned yw[NR][4][4]; u32x2 dw[NR][4];
            const bf16_t* DELTA = (const bf16_t*)(WSP(F) + WS_DELTA);
#pragma unroll
            for (int q = 0; q < NR; ++q)
#pragma unroll
                for (int j = 0; j < 4; ++j) dw[q][j] = *((const u32x2*)(DELTA + (size_t)row[q] * DM) + F.lane + 64 * j);
#pragma unroll
            for (int q = 0; q < NR; ++q)
#pragma unroll
                for (int k = 0; k < 4; ++k) { const int e = rc[q][k].x >> 15, pos = rc[q][k].x & 32767;
                    const unsigned char* yp = Y2 + (size_t)(tab[32 + e] * 256 + pos) * DM;
#pragma unroll
                    for (int j = 0; j < 4; ++j) yw[q][k][j] = *((const unsigned*)yp + F.lane + 64 * j); }
#pragma unroll
            for (int q = 0; q < NR; ++q) {
                const float* m5 = modv + (size_t)((l - 1) * 5 + rr[q]) * 6144 + 5 * 1024;
#pragma unroll
                for (int j = 0; j < 4; ++j) { f32x4 acc = (f32x4){0.f, 0.f, 0.f, 0.f};
#pragma unroll
                    for (int k = 0; k < 4; ++k) { const int w = (int)yw[q][k][j]; const f32x2 lo = __builtin_amdgcn_cvt_pk_f32_fp8(w, false), hi = __builtin_amdgcn_cvt_pk_f32_fp8(w, true);
                        acc += (__int_as_float(rc[q][k].y) * (1.f / Q8_Y)) * (f32x4){lo.x, lo.y, hi.x, hi.y}; }
                    v[q][j] += (f32x4){bflo(dw[q][j].x), bfhi(dw[q][j].x), bflo(dw[q][j].y), bfhi(dw[q][j].y)} + *((const f32x4*)m5 + F.lane + 64 * j) * acc; } }
        }
#pragma unroll
        for (int q = 0; q < NR; ++q) {
            if (!ok[q]) continue;
#pragma unroll
            for (int j = 0; j < 4; ++j) { if (l == 4) *((f32x4*)hp[q] + F.lane + 64 * j) = v[q][j];
                else { u32x2 hw; hw.x = cvt_pk_bf16(v[q][j].x, v[q][j].y); hw.y = cvt_pk_bf16(v[q][j].z, v[q][j].w); *((u32x2*)(HB + (size_t)row[q] * DM) + F.lane + 64 * j) = hw; } }
        }
        if (l < 4) {
            float ss[NR];
#pragma unroll
            for (int q = 0; q < NR; ++q) { ss[q] = 0.f;
#pragma unroll
                for (int j = 0; j < 4; ++j) ss[q] += (v[q][j].x * v[q][j].x + v[q][j].y * v[q][j].y) + (v[q][j].z * v[q][j].z + v[q][j].w * v[q][j].w); }
#pragma unroll
        for (int q = 0; q < NR; ++q) ss[q] = wave_sum(ss[q], F.lane);
            const float* g1 = INP(F, I_N1G) + l * DM;
#pragma unroll
            for (int q = 0; q < NR; ++q) {
                if (!ok[q]) continue;
                const float rstd = rsqrtf(ss[q] * (1.f / DM) + NORM_EPS);
                const float* m0 = modv + (size_t)(l * 5 + rr[q]) * 6144; const float* m1 = m0 + 1024;
#pragma unroll
                for (int j = 0; j < 4; ++j) { const f32x4 g = *((const f32x4*)g1 + F.lane + 64 * j), sh = *((const f32x4*)m0 + F.lane + 64 * j), sc = *((const f32x4*)m1 + F.lane + 64 * j);
                    const f32x4 u = v[q][j] * rstd * g * (sc + 1.f) + sh;
                    u32x2 w; w.x = cvt_pk_bf16(u.x, u.y); w.y = cvt_pk_bf16(u.z, u.w);
                    *((u32x2*)(U + (size_t)row[q] * DM) + F.lane + 64 * j) = w; }
            }
        }
    }
}

__device__ __forceinline__ void route_row(float (&p)[8], float rb, int lane, bool ok, int lr, LAS float* lg) {
    const int hi16 = (lane >> 4) & 1, hi8 = (lane >> 3) & 1, hi4 = (lane >> 2) & 1;
#pragma unroll
    for (int i = 0; i < 4; ++i) { const float send = hi16 ? p[i] : p[i + 4], keep = hi16 ? p[i + 4] : p[i]; p[i] = keep + xch<16>(send, lane); }
#pragma unroll
    for (int i = 0; i < 2; ++i) { const float send = hi8 ? p[i] : p[i + 2], keep = hi8 ? p[i + 2] : p[i]; p[i] = keep + xch<8>(send, lane); }
    { const float send = hi4 ? p[0] : p[1], keep = hi4 ? p[1] : p[0]; p[0] = keep + xch<4>(send, lane); }
    const float val = p[0] + xch<32>(p[0], lane) + rb;
    if (lane < 32 && ok) lg[lr * 33 + lane] = val;
}
__device__ __forceinline__ void phase_e(const Frame& F0, int l) {
    Frame F = refresh(F0);
    constexpr int VSTR = 2064, VL_OFF = 24 * VSTR, RED_OFF = 2 * 24 * VSTR;
    static_assert(RED_OFF + 8 * 2 * 24 * 16 * 4 <= TAB_OFF, "phase E router LDS map");
    LAS float* red = (LAS float*)(F.lds + RED_OFF);
    LAS int* cntl = (LAS int*)(F.lds + TAB_OFF);
    LAS int* basel = cntl + 32;
    LAS int* recs = cntl + 64;
    LAS float* lg = (LAS float*)(recs + 272 * 4);
    static_assert(TAB_OFF + 256 + 272 * 16 + 68 * 33 * 4 <= MISC_OFF, "phase E LDS map");
    const bool lastl = (l == DEPTH - 1);
    bf16x8 bw[4][2][2];
    { const bf16x8* src = (const bf16x8*)(WSP(F) + WS_ROUTW) + (size_t)(l * 8 + F.wave) * (4 * 2 * 2 * 64) + F.lane;
#pragma unroll
      for (int kk = 0; kk < 4; ++kk)
#pragma unroll
          for (int n = 0; n < 2; ++n) { bw[kk][n][0] = src[((kk * 2 + n) * 2 + 0) * 64]; bw[kk][n][1] = src[((kk * 2 + n) * 2 + 1) * 64]; }
      if (F.tid < 32) cntl[F.tid] = 0; }
    __syncthreads();
    const float* modv = (const float*)(WSP(F) + WS_MODV);
    const bf16_t* HB = (const bf16_t*)(WSP(F) + WS_HB);
    unsigned char* U8 = WSP(F) + WS_U;
    constexpr int RPB = NTOK / 256;
    const float rb = INP(F, I_RB)[l * 32 + (F.lane & 31)];
    int pass = 0;
    const float* g2 = INP(F, I_N2G) + l * DM;
    const bf16_t* DELTA = (const bf16_t*)(WSP(F) + WS_DELTA);
#pragma nounroll
    for (int lr0 = F.wave; lr0 < RPB; lr0 += 8 * 3) {
        constexpr int NR = 3;
        int lrq[NR], row[NR]; bool ok[NR]; f32x4 v[NR][4]; float ss[NR];
#pragma unroll
        for (int q = 0; q < NR; ++q) { lrq[q] = lr0 + 8 * q; ok[q] = lrq[q] < RPB; if (!ok[q]) lrq[q] = lr0; row[q] = F.bid * RPB + lrq[q];
            const bool isctx = row[q] < NCTXR;
            (void)isctx; const bf16_t* hp = HB + (size_t)row[q] * DM;
            ss[q] = 0.f;
#pragma unroll
            for (int j = 0; j < 4; ++j) { const u32x2 dw = *((const u32x2*)(DELTA + (size_t)row[q] * DM) + F.lane + 64 * j);
                const u32x2 hw = *((const u32x2*)hp + F.lane + 64 * j);
                v[q][j] = (f32x4){bflo(hw.x), bfhi(hw.x), bflo(hw.y), bfhi(hw.y)} + (f32x4){bflo(dw.x), bfhi(dw.x), bflo(dw.y), bfhi(dw.y)}; ss[q] += (v[q][j].x * v[q][j].x + v[q][j].y * v[q][j].y) + (v[q][j].z * v[q][j].z + v[q][j].w * v[q][j].w); } }
#pragma unroll
        for (int q = 0; q < NR; ++q) ss[q] = wave_sum(ss[q], F.lane);
#pragma unroll
        for (int q = 0; q < NR; ++q) {
            const int r = row[q] < NCTXR ? 4 : ((row[q] - NCTXR) >> 12);
            const float rstd = rsqrtf(ss[q] * (1.f / DM) + NORM_EPS);
            const float* m3 = modv + (size_t)(l * 5 + r) * 6144 + 3 * 1024; const float* m4 = m3 + 1024;
#pragma unroll
            for (int j = 0; j < 4; ++j) { const f32x4 g = *((const f32x4*)g2 + F.lane + 64 * j), sh = *((const f32x4*)m3 + F.lane + 64 * j), sc = *((const f32x4*)m4 + F.lane + 64 * j);
                v[q][j] = v[q][j] * rstd * g * (sc + 1.f) + sh;
                if (ok[q]) *((unsigned*)(U8 + (size_t)row[q] * DM) + F.lane + 64 * j) = pk4_fp8(v[q][j].x, v[q][j].y, v[q][j].z, v[q][j].w, Q8_U);
                { u32x2 h, o; h.x = cvt_pk_bf16(v[q][j].x, v[q][j].y); h.y = cvt_pk_bf16(v[q][j].z, v[q][j].w);
                  o.x = cvt_pk_bf16(v[q][j].x - bflo(h.x), v[q][j].y - bfhi(h.x)); o.y = cvt_pk_bf16(v[q][j].z - bflo(h.y), v[q][j].w - bfhi(h.y));
                  LAS unsigned char* vp = F.lds + (F.wave + 8 * q) * VSTR + (F.lane + 64 * j) * 8;
                  *(LAS u32x2*)vp = h; *(LAS u32x2*)(vp + VL_OFF) = o; } } }
        __syncthreads();
        {
            const int fr = F.lane & 15, fq = F.lane >> 4;
            f32x4 acc[2][2];
#pragma unroll
            for (int m = 0; m < 2; ++m)
#pragma unroll
                for (int n = 0; n < 2; ++n) acc[m][n] = (f32x4){0.f, 0.f, 0.f, 0.f};
#pragma unroll
            for (int kk = 0; kk < 4; ++kk)
#pragma unroll
                for (int m = 0; m < 2; ++m) {
                    const LAS unsigned char* ap = F.lds + (m * 16 + fr) * VSTR + ((F.wave * 4 + kk) * 32 + fq * 8) * 2;
                    const bf16x8 ah = *(const LAS bf16x8*)ap, al = *(const LAS bf16x8*)(ap + VL_OFF);
#pragma unroll
                    for (int n = 0; n < 2; ++n) { acc[m][n] = __builtin_amdgcn_mfma_f32_16x16x32_bf16(ah, bw[kk][n][0], acc[m][n], 0, 0, 0); acc[m][n] = __builtin_amdgcn_mfma_f32_16x16x32_bf16(ah, bw[kk][n][1], acc[m][n], 0, 0, 0); acc[m][n] = __builtin_amdgcn_mfma_f32_16x16x32_bf16(al, bw[kk][n][0], acc[m][n], 0, 0, 0); }
                }
#pragma unroll
            for (int m = 0; m < 2; ++m)
#pragma unroll
                for (int n = 0; n < 2; ++n)
#pragma unroll
                    for (int j = 0; j < 4; ++j) { const int r = m * 16 + fq * 4 + j; if (r < 24) red[((F.wave * 2 + n) * 24 + r) * 16 + fr] = acc[m][n][j]; }
        }
        __syncthreads();
#pragma unroll
        for (int h = 0; h < 2; ++h) { const int o = F.tid + 512 * h;
            if (o < 24 * 32) { const int r = o >> 5, e = o & 31, lr = pass * 24 + r;
                float sum = rb;
#pragma unroll
                for (int w = 0; w < 8; ++w) sum += red[((w * 2 + (e >> 4)) * 24 + r) * 16 + (e & 15)];
                if (lr < RPB) lg[lr * 33 + e] = sum; } }
        ++pass;
    }
    __syncthreads();
    int nrec = 0;
    if (F.tid < RPB) {
        const int lr = F.tid, row = F.bid * RPB + lr;
        if (!(lastl && row < NCTXR)) {
            float v0 = -3.0e38f, v1 = -3.0e38f, v2 = -3.0e38f, v3 = -3.0e38f; int i0 = 0, i1 = 0, i2 = 0, i3 = 0;
            for (int e = 0; e < 32; ++e) { float t = lg[lr * 33 + e]; int ti = e;
                if (t > v0) { const float a = v0; v0 = t; t = a; const int b = i0; i0 = ti; ti = b; }
                if (t > v1) { const float a = v1; v1 = t; t = a; const int b = i1; i1 = ti; ti = b; }
                if (t > v2) { const float a = v2; v2 = t; t = a; const int b = i2; i2 = ti; ti = b; }
                if (t > v3) { v3 = t; i3 = ti; } }
            const float e1 = __expf(v1 - v0), e2 = __expf(v2 - v0), e3 = __expf(v3 - v0);
            const float inv = 1.f / (1.f + e1 + e2 + e3);
            const float gk[4] = {inv, e1 * inv, e2 * inv, e3 * inv}; const int te[4] = {i0, i1, i2, i3};
#pragma unroll
            for (int k = 0; k < 4; ++k) { const int lp = atomicAdd((int*)(cntl + te[k]), 1); LAS int* rp = recs + (lr * 4 + k) * 4; rp[0] = row; rp[1] = te[k]; rp[2] = lp; rp[3] = __float_as_int(gk[k]); }
            nrec = 1;
        } else { recs[(lr * 4) * 4] = -1; recs[(lr * 4 + 1) * 4] = -1; recs[(lr * 4 + 2) * 4] = -1; recs[(lr * 4 + 3) * 4] = -1; }
    }
    (void)nrec;
    __syncthreads();
    if (F.tid < 32) { unsigned* cnt = (unsigned*)(WSP(F) + WS_CTL) + CW_CNT + l * 32; basel[F.tid] = (int)atomicAdd(cnt + F.tid, (unsigned)cntl[F.tid]); }
    __syncthreads();
    int* slottok = (int*)(WSP(F) + WS_SLOTTOK); int2* tokrec = (int2*)(WSP(F) + WS_TOKREC);
    for (int i = F.tid; i < RPB * 4; i += 512) { const LAS int* rp = recs + i * 4; const int row = rp[0]; if (row < 0) continue; const int e = rp[1], pos = basel[e] + rp[2];
        slottok[e * NTOK + pos] = row; tokrec[row * 4 + (i & 3)] = make_int2((e << 15) | pos, rp[3]); }
    __syncthreads();
}

__device__ __forceinline__ bf16x8 lds_frag(const LAS bf16_t* base, int ld, int row0, int k0, int fr, int fq) {
    return *(const LAS bf16x8*)(base + (row0 + fr) * ld + k0 + fq * 8);
}
#define MMA16(a, b, c) __builtin_amdgcn_mfma_f32_16x16x32_bf16(a, b, c, 0, 0, 0)

__device__ __forceinline__ int scan_row(int b, int dir, int p) {
    if (p < CTXL) return b * CTXL + (dir ? CTXL - 1 - p : p);
    const int pl = p - CTXL; return NCTXR + b * SEQ + (dir ? SEQ - 1 - pl : pl);
}
__device__ __forceinline__ void tri_tile(int id, int& ti, int& si) { ti = id >= 6 ? 3 : id >= 3 ? 2 : id >= 1 ? 1 : 0; si = id - (ti * (ti + 1)) / 2; }

__device__ __forceinline__ void phase_c1a(const Frame& F0, int jl) {
    Frame F = refresh(F0);
    const int gw = F.bid * 8 + F.wave, NGW = F.G * 8;
    const bf16_t* P = (const bf16_t*)(WSP(F) + WS_P);
    bf16_t* QK = (bf16_t*)(WSP(F) + WS_AUX + AUX_QK);
    const float* cw = INP(F, I_MCONV) + (size_t)jl * 3 * 1024;
    f32x4 w0[4], w1[4], w2[4];
#pragma unroll
    for (int j = 0; j < 4; ++j) { w0[j] = *((const f32x4*)cw + F.lane + 64 * j); w1[j] = *((const f32x4*)(cw + 1024) + F.lane + 64 * j); w2[j] = *((const f32x4*)(cw + 2048) + F.lane + 64 * j); }
    for (int row0 = gw; row0 < NTOK; row0 += 2 * NGW) {
        int rw[2]; bool okr[2]; u32x2 c0[2][4], cm[2][4], cp[2][4];
#pragma unroll
        for (int q = 0; q < 2; ++q) { rw[q] = row0 + q * NGW; okr[q] = rw[q] < NTOK; if (!okr[q]) rw[q] = row0;
            const int row = rw[q];
            const bool isctx = row < NCTXR; const int t = isctx ? (row & (CTXL - 1)) : ((row - NCTXR) & (SEQ - 1)); const int tl = isctx ? CTXL - 1 : SEQ - 1;
            const bool hp = t > 0, hn = t < tl;
            const bf16_t* pr = P + (size_t)row * NPAD_A;
#pragma unroll
            for (int j = 0; j < 4; ++j) {
                c0[q][j] = *((const u32x2*)pr + F.lane + 64 * j);
                cm[q][j] = (u32x2){0u, 0u}; cp[q][j] = (u32x2){0u, 0u};
                if (hp) cm[q][j] = *((const u32x2*)(pr - NPAD_A) + F.lane + 64 * j);
                if (hn) cp[q][j] = *((const u32x2*)(pr + NPAD_A) + F.lane + 64 * j); } }
#pragma unroll
        for (int q = 0; q < 2; ++q) {
            if (!okr[q]) continue;
#pragma unroll
            for (int j = 0; j < 4; ++j) {
                f32x4 x = w0[j] * (f32x4){bflo(cm[q][j].x), bfhi(cm[q][j].x), bflo(cm[q][j].y), bfhi(cm[q][j].y)} + w1[j] * (f32x4){bflo(c0[q][j].x), bfhi(c0[q][j].x), bflo(c0[q][j].y), bfhi(c0[q][j].y)}
                        + w2[j] * (f32x4){bflo(cp[q][j].x), bfhi(cp[q][j].x), bflo(cp[q][j].y), bfhi(cp[q][j].y)};
                const float sc = (j < 2) ? 0.125f : 1.f;
                x.x = sc * x.x * sigmoidf_(x.x); x.y = sc * x.y * sigmoidf_(x.y); x.z = sc * x.z * sigmoidf_(x.z); x.w = sc * x.w * sigmoidf_(x.w);
                u32x2 w; w.x = cvt_pk_bf16(x.x, x.y); w.y = cvt_pk_bf16(x.z, x.w);
                *((u32x2*)(QK + (size_t)rw[q] * DM) + F.lane + 64 * j) = w;
            }
        }
    }
    const float* gb = INP(F, I_MGB) + jl * 32;
    f32x4* G = (f32x4*)(WSP(F) + WS_GATES);
    for (int ch = gw; ch < NTOK / 64; ch += NGW) {
        const int row = ch * 64 + F.lane;
        const u32x4* gp = (const u32x4*)(P + (size_t)row * NPAD_A + 3072);
        unsigned gwd[16];
#pragma unroll
        for (int q = 0; q < 4; ++q) { const u32x4 w = gp[q]; gwd[q * 4] = w.x; gwd[q * 4 + 1] = w.y; gwd[q * 4 + 2] = w.z; gwd[q * 4 + 3] = w.w; }
#pragma unroll
        for (int h = 0; h < 8; ++h) {
            const float i_f = ((h & 1) ? bfhi(gwd[(0 + h) >> 1]) : bflo(gwd[(0 + h) >> 1])) + gb[h];
            const float f_f = ((h & 1) ? bfhi(gwd[(8 + h) >> 1]) : bflo(gwd[(8 + h) >> 1])) + gb[8 + h];
            const float i_b = ((h & 1) ? bfhi(gwd[(16 + h) >> 1]) : bflo(gwd[(16 + h) >> 1])) + gb[16 + h];
            const float f_b = ((h & 1) ? bfhi(gwd[(24 + h) >> 1]) : bflo(gwd[(24 + h) >> 1])) + gb[24 + h];
            float bf_ = logsigmoidf_(f_f), bb_ = logsigmoidf_(f_b);
#pragma unroll
            for (int d = 1; d < 64; d <<= 1) { const float tf = shup(bf_, d, F.lane), tb = shdn(bb_, d, F.lane); if (F.lane >= d) bf_ += tf; if (F.lane + d < 64) bb_ += tb; }
            const float af = i_f - bf_, ab_ = i_b - bb_;
            float pf = af, pb = ab_;
#pragma unroll
            for (int d = 1; d < 64; d <<= 1) { const float tf = shup(pf, d, F.lane), tb = shdn(pb, d, F.lane); if (F.lane >= d) pf = fmaxf(pf, tf); if (F.lane + d < 64) pb = fmaxf(pb, tb); }
            G[(size_t)row * 16 + h] = (f32x4){af, bf_, pf, 0.f};
            G[(size_t)row * 16 + 8 + h] = (f32x4){ab_, bb_, pb, 0.f};
        }
    }
}

__device__ __forceinline__ unsigned off_b(unsigned row, unsigned ch) { return 256u * row + 16u * (ch ^ (((row & 3u) << 2) | ((row >> 2) & 3u))); }
__device__ __forceinline__ unsigned tr_addr16(unsigned lane, unsigned c, unsigned ks, unsigned t) {
    const unsigned g = lane >> 4, q = (lane & 15u) >> 2, p = lane & 3u;
    return off_b(32u * ks + 8u * g + 4u * t + q, 2u * c + (p >> 1)) + 8u * (p & 1u);
}
typedef short s16x4 __attribute__((ext_vector_type(4)));
__device__ __forceinline__ s16x4 tr_read(unsigned addr) { s16x4 r; asm volatile("ds_read_b64_tr_b16 %0, %1" : "=&v"(r) : "v"(addr) : "memory"); return r; }
#define TR_WAIT2(a, b) asm volatile("s_waitcnt lgkmcnt(0)" : "+v"(a), "+v"(b) :: "memory")
__device__ __forceinline__ bf16x8 cat4(s16x4 lo, s16x4 hi) { return (bf16x8){lo[0], lo[1], lo[2], lo[3], hi[0], hi[1], hi[2], hi[3]}; }

__device__ __forceinline__ void phase_c2a(const Frame& F0, bool last_layer, int cl0, int cl1) {
    Frame F = refresh(F0);
    if (F.bid >= 64) {
        if (cl1 - cl0 == 1) { if (F.wave < 4) moe_convert(F, cl0, cl1, (F.bid - 64) * 4 + F.wave, (F.G - 64) * 4); }
        else if (cl1 > cl0) moe_convert(F, cl0, cl1, (F.bid - 64) * 8 + F.wave, (F.G - 64) * 8);
        return; }
    const int b = F.bid >> 4, h = (F.bid >> 1) & 7, dir = F.bid & 1;
    constexpr int LD = 72, NCH = (CTXL + SEQ) / 64, LH = 136;
    constexpr int O_KS = 2 * 64 * LD * 2, O_KW = O_KS / 2 * 2 + 0, IN_BYTES = 2 * 64 * LD * 2 + 8192 + 16384 + 1024;
    constexpr int OFF_KW = 2 * 64 * LD * 2, OFF_V = OFF_KW + 8192, OFF_AB = OFF_V + 16384;
    LAS unsigned char* L0 = F.lds;
    LAS bf16_t* Sb = (LAS bf16_t*)(L0 + 2 * IN_BYTES); LAS bf16_t* Hs = Sb + 64 * LD;
    LAS float* MT = (LAS float*)(Hs + 64 * LH);
    LAS float* rdn_s = MT + 4 * NCH;
    constexpr int LDS_USED = 2 * IN_BYTES + 64 * LD * 2 + 64 * LH * 2 + 4 * NCH * 4 + 256;
    static_assert(LDS_USED <= MISC_OFF && (O_KS | O_KW) >= 0, "C2a LDS map");
    { LAS unsigned* z = (LAS unsigned*)L0; for (int i = F.tid; i < LDS_USED / 4; i += 512) z[i] = 0u; }
    const bf16_t* QK = (const bf16_t*)(WSP(F) + WS_AUX + AUX_QK);
    const bf16_t* P = (const bf16_t*)(WSP(F) + WS_P);
    const f32x4* G = (const f32x4*)(WSP(F) + WS_GATES);
    bf16_t* HD = (bf16_t*)(WSP(F) + WS_HDIR) + (size_t)dir * NTOK * DM;
    __syncthreads();
    if (F.tid < NCH) { const f32x4 g = G[(size_t)scan_row(b, dir, F.tid * 64 + 63) * 16 + dir * 8 + h]; MT[2 * NCH + F.tid] = g.y; MT[3 * NCH + F.tid] = g.z; }
    __syncthreads();
    if (F.tid == 0) { float m = 0.f;
        for (int c = 0; c < NCH; ++c) { const float cm63 = fmaxf(m, MT[3 * NCH + c]); MT[c] = m; MT[NCH + c] = cm63; m = MT[2 * NCH + c] + cm63; } }
    __syncthreads();
    const int fr = F.lane & 15, fq = F.lane >> 4;
    const int qr = F.tid >> 3, qc = F.tid & 7;
    u32x4 rq, rk, rv0, rv1; float ra = 0.f; f32x4 rab = (f32x4){0.f, 0.f, 0.f, 0.f};
#define C2A_LOAD(c) do { const int p0_ = (c) * 64; \
        const size_t rowq = (size_t)scan_row(b, dir, p0_ + qr); \
        rq = *(const u32x4*)(QK + rowq * DM + h * 64 + qc * 8); rk = *(const u32x4*)(QK + rowq * DM + 512 + h * 64 + qc * 8); \
        ra = ((const float*)(G + rowq * 16 + dir * 8 + h))[0]; \
        rv0 = *(const u32x4*)(P + (size_t)scan_row(b, dir, p0_ + (F.tid >> 4)) * NPAD_A + 1024 + h * 128 + (F.tid & 15) * 8); \
        rv1 = *(const u32x4*)(P + (size_t)scan_row(b, dir, p0_ + 32 + (F.tid >> 4)) * NPAD_A + 1024 + h * 128 + (F.tid & 15) * 8); \
        if (F.tid < 64) rab = G[(size_t)scan_row(b, dir, p0_ + F.tid) * 16 + dir * 8 + h]; } while (0)
#define C2A_STAGE(c, buf) do { LAS unsigned char* B_ = L0 + (buf) * IN_BYTES; \
        *(LAS u32x4*)(B_ + (qr * LD + qc * 8) * 2) = rq; *(LAS u32x4*)(B_ + 64 * LD * 2 + (qr * LD + qc * 8) * 2) = rk; \
        { const float wg_ = __expf(ra - MT[NCH + (c)]); u32x4 kw_; \
          kw_.x = cvt_pk_bf16(bflo(rk.x) * wg_, bfhi(rk.x) * wg_); kw_.y = cvt_pk_bf16(bflo(rk.y) * wg_, bfhi(rk.y) * wg_); kw_.z = cvt_pk_bf16(bflo(rk.z) * wg_, bfhi(rk.z) * wg_); kw_.w = cvt_pk_bf16(bflo(rk.w) * wg_, bfhi(rk.w) * wg_); \
          *(LAS u32x4*)(B_ + OFF_KW + off_b(qr & 31, 8 * (qr >> 5) + qc)) = kw_; } \
        *(LAS u32x4*)(B_ + OFF_V + off_b(F.tid >> 4, F.tid & 15)) = rv0; *(LAS u32x4*)(B_ + OFF_V + off_b(32 + (F.tid >> 4), F.tid & 15)) = rv1; \
        if (F.tid < 64) { const float mc_ = MT[(c)], cm_ = fmaxf(mc_, rab.z); \
            ((LAS f32x4*)(B_ + OFF_AB))[F.tid] = (f32x4){rab.x, cm_, __expf(mc_ - cm_), __expf(-(rab.y + cm_))}; } } while (0)
    C2A_LOAD(0); C2A_STAGE(0, 0); C2A_LOAD(1);
    f32x4 CT[4], CN[4];
#pragma unroll
    for (int i = 0; i < 4; ++i) { CT[i] = (f32x4){0.f, 0.f, 0.f, 0.f}; CN[i] = (f32x4){0.f, 0.f, 0.f, 0.f}; }
    unsigned one2; asm volatile("v_mov_b32 %0, 0x3f803f80" : "=v"(one2));
    const bf16x8 ONES = __builtin_bit_cast(bf16x8, (u32x4){one2, one2, one2, one2});
    const unsigned lbase = (unsigned)(size_t)L0;
    for (int c = 0; c <= NCH; ++c) {
        __syncthreads();
        const int buf = c & 1;
        if (c + 1 < NCH) C2A_STAGE(c + 1, buf ^ 1);
        if (c > 0 && !(last_layer && c - 1 < CTXL / 64)) {
            const int row0 = scan_row(b, dir, (c - 1) * 64), rstep = dir ? -1 : 1;
#pragma unroll
            for (int i = 0; i < 2; ++i) { const int pc = F.tid + 512 * i, r_ = pc >> 4, ch_ = pc & 15;
                const u32x4 nw = *(const LAS u32x4*)(Hs + r_ * LH + ch_ * 8); const float rd_ = rdn_s[r_];
                u32x4 hw; hw.x = cvt_pk_bf16(bflo(nw.x) * rd_, bfhi(nw.x) * rd_); hw.y = cvt_pk_bf16(bflo(nw.y) * rd_, bfhi(nw.y) * rd_); hw.z = cvt_pk_bf16(bflo(nw.z) * rd_, bfhi(nw.z) * rd_); hw.w = cvt_pk_bf16(bflo(nw.w) * rd_, bfhi(nw.w) * rd_);
                *(u32x4*)(HD + (size_t)(row0 + rstep * r_) * DM + h * 128 + ch_ * 8) = hw; }
        }
        if (c == NCH) break;
        if (c + 2 < NCH) C2A_LOAD(c + 2);
        const LAS bf16_t* Qs = (const LAS bf16_t*)(L0 + buf * IN_BYTES); const LAS bf16_t* Ks = Qs + 64 * LD;
        const LAS f32x4* AB = (const LAS f32x4*)(L0 + buf * IN_BYTES + OFF_AB);
        const float mc = MT[c];
        for (int id = F.wave; id < 10; id += 8) {
            int ti, si; tri_tile(id, ti, si);
            f32x4 acc = (f32x4){0.f, 0.f, 0.f, 0.f};
#pragma unroll
            for (int kk = 0; kk < 2; ++kk) acc = MMA16(lds_frag(Qs, LD, ti * 16, kk * 32, fr, fq), lds_frag(Ks, LD, si * 16, kk * 32, fr, fq), acc);
            const int s_ = si * 16 + fr; const float as = AB[s_].x;
#pragma unroll
            for (int j = 0; j < 4; ++j) { const int t = ti * 16 + fq * 4 + j; const float w = (s_ <= t) ? __expf(as - AB[t].y) : 0.f; Sb[t * LD + s_] = f2bf(acc[j] * w); }
        }
        __syncthreads();
        const float decay = __expf(mc - MT[NCH + c]);
        const unsigned vbase = lbase + buf * IN_BYTES + OFF_V, kbase = lbase + buf * IN_BYTES + OFF_KW;
        s16x4 v00 = tr_read(vbase + tr_addr16(F.lane, F.wave, 0, 0)), v01 = tr_read(vbase + tr_addr16(F.lane, F.wave, 0, 1));
        s16x4 v10 = tr_read(vbase + tr_addr16(F.lane, F.wave, 1, 0)), v11 = tr_read(vbase + tr_addr16(F.lane, F.wave, 1, 1));
        TR_WAIT2(v00, v01); TR_WAIT2(v10, v11);
        const bf16x8 vf0 = cat4(v00, v01), vf1 = cat4(v10, v11);
        const bool denw = F.wave < 4;
        bf16x8 cb[2], nb[2];
#pragma unroll
        for (int kk = 0; kk < 2; ++kk) {
            u32x4 w; w.x = cvt_pk_bf16(CT[2 * kk][0], CT[2 * kk][1]); w.y = cvt_pk_bf16(CT[2 * kk][2], CT[2 * kk][3]); w.z = cvt_pk_bf16(CT[2 * kk + 1][0], CT[2 * kk + 1][1]); w.w = cvt_pk_bf16(CT[2 * kk + 1][2], CT[2 * kk + 1][3]);
            cb[kk] = __builtin_bit_cast(bf16x8, w);
            u32x4 x; x.x = cvt_pk_bf16(CN[2 * kk][0], CN[2 * kk][1]); x.y = cvt_pk_bf16(CN[2 * kk][2], CN[2 * kk][3]); x.z = cvt_pk_bf16(CN[2 * kk + 1][0], CN[2 * kk + 1][1]); x.w = cvt_pk_bf16(CN[2 * kk + 1][2], CN[2 * kk + 1][3]);
            nb[kk] = __builtin_bit_cast(bf16x8, x); }
#pragma unroll
        for (int ti = 0; ti < 4; ++ti) {
            f32x4 aC = (f32x4){0.f, 0.f, 0.f, 0.f}, aS = aC;
            bf16x8 qa[2];
#pragma unroll
            for (int kk = 0; kk < 2; ++kk) {
                const u32x2 qlo = *(const LAS u32x2*)(Qs + (ti * 16 + fr) * LD + kk * 32 + 4 * fq), qhi = *(const LAS u32x2*)(Qs + (ti * 16 + fr) * LD + kk * 32 + 16 + 4 * fq);
                const u32x4 qw = (u32x4){qlo.x, qlo.y, qhi.x, qhi.y}; qa[kk] = __builtin_bit_cast(bf16x8, qw);
                aC = MMA16(qa[kk], cb[kk], aC); }
            const bf16x8 sa0 = lds_frag(Sb, LD, ti * 16, 0, fr, fq); aS = MMA16(sa0, vf0, aS);
            bf16x8 sa1 = sa0; if (ti >= 2) { sa1 = lds_frag(Sb, LD, ti * 16, 32, fr, fq); aS = MMA16(sa1, vf1, aS); }
            f32x4 gg[4];
#pragma unroll
            for (int j = 0; j < 4; ++j) gg[j] = AB[ti * 16 + fq * 4 + j];
#pragma unroll
            for (int j = 0; j < 4; ++j) Hs[(ti * 16 + fq * 4 + j) * LH + F.wave * 16 + fr] = f2bf(gg[j].z * aC[j] + aS[j]);
            if (denw && F.wave == ti) {
                f32x4 aCn = (f32x4){0.f, 0.f, 0.f, 0.f}, aSn = aCn;
                aCn = MMA16(qa[0], nb[0], aCn); aCn = MMA16(qa[1], nb[1], aCn);
                aSn = MMA16(sa0, ONES, aSn); if (ti >= 2) aSn = MMA16(sa1, ONES, aSn);
                if (fr == 0) {
#pragma unroll
                    for (int j = 0; j < 4; ++j) rdn_s[ti * 16 + fq * 4 + j] = __builtin_amdgcn_rcpf(fmaxf(fabsf(gg[j].z * aCn[j] + aSn[j]), gg[j].w)); }
            }
        }
        s16x4 kq[4][4];
#pragma unroll
        for (int di = 0; di < 4; ++di) { kq[di][0] = tr_read(kbase + tr_addr16(F.lane, di, 0, 0)); kq[di][1] = tr_read(kbase + tr_addr16(F.lane, di, 0, 1));
            kq[di][2] = tr_read(kbase + tr_addr16(F.lane, 4 + di, 0, 0)); kq[di][3] = tr_read(kbase + tr_addr16(F.lane, 4 + di, 0, 1)); }
#pragma unroll
        for (int di = 0; di < 4; ++di) { TR_WAIT2(kq[di][0], kq[di][1]); TR_WAIT2(kq[di][2], kq[di][3]); }
#pragma unroll
        for (int di = 0; di < 4; ++di) {
            const bf16x8 kf0 = cat4(kq[di][0], kq[di][1]), kf1 = cat4(kq[di][2], kq[di][3]);
            f32x4 a = CT[di] * decay;
            a = MMA16(kf0, vf0, a); a = MMA16(kf1, vf1, a); CT[di] = a;
            if (denw) { f32x4 an = CN[di] * decay; an = MMA16(kf0, ONES, an); an = MMA16(kf1, ONES, an); CN[di] = an; }
        }
    }
#undef C2A_LOAD
#undef C2A_STAGE
}

__device__ __forceinline__ void phase_c3a(const Frame& F0, int jl) {
    Frame F = refresh(F0);
    const int gw = F.bid * 8 + F.wave, NGW = F.G * 8;
    const bf16_t* P = (const bf16_t*)(WSP(F) + WS_P);
    const bf16_t* H0 = (const bf16_t*)(WSP(F) + WS_HDIR); const bf16_t* H1 = H0 + (size_t)NTOK * DM;
    bf16_t* Y = (bf16_t*)(WSP(F) + WS_YPRE);
    const float* ng = INP(F, I_MNG) + (size_t)jl * DM;
    f32x4 g[4];
#pragma unroll
    for (int j = 0; j < 4; ++j) g[j] = *((const f32x4*)ng + F.lane + 64 * j);
    constexpr int NR = 4;
    for (int row0 = gw; row0 < NTOK; row0 += NR * NGW) {
        int row[NR]; bool ok[NR]; u32x2 a[NR][4], bq[NR][4], ov[NR][4];
#pragma unroll
        for (int q = 0; q < NR; ++q) { row[q] = row0 + q * NGW; ok[q] = row[q] < NTOK; if (!ok[q]) row[q] = row0;
#pragma unroll
            for (int j = 0; j < 4; ++j) {
                a[q][j] = *((const u32x2*)(H0 + (size_t)row[q] * DM) + F.lane + 64 * j); bq[q][j] = *((const u32x2*)(H1 + (size_t)row[q] * DM) + F.lane + 64 * j);
                ov[q][j] = *((const u32x2*)(P + (size_t)row[q] * NPAD_A + 2048) + F.lane + 64 * j); } }
        f32x4 x[NR][4]; float ss[NR][4];
#pragma unroll
        for (int q = 0; q < NR; ++q)
#pragma unroll
            for (int j = 0; j < 4; ++j) { x[q][j] = (f32x4){bflo(a[q][j].x) + bflo(bq[q][j].x), bfhi(a[q][j].x) + bfhi(bq[q][j].x), bflo(a[q][j].y) + bflo(bq[q][j].y), bfhi(a[q][j].y) + bfhi(bq[q][j].y)};
                ss[q][j] = (x[q][j].x * x[q][j].x + x[q][j].y * x[q][j].y) + (x[q][j].z * x[q][j].z + x[q][j].w * x[q][j].w); }
#pragma unroll
        for (int q = 0; q < NR; ++q)
#pragma unroll
            for (int j = 0; j < 4; ++j) ss[q][j] = half_sum(ss[q][j]);
#pragma unroll
        for (int q = 0; q < NR; ++q) {
            if (!ok[q]) continue;
#pragma unroll
            for (int j = 0; j < 4; ++j) {
                const float rstd = rsqrtf(ss[q][j] * (1.f / 128.f) + NORM_EPS);
                const f32x4 o4 = (f32x4){bflo(ov[q][j].x), bfhi(ov[q][j].x), bflo(ov[q][j].y), bfhi(ov[q][j].y)};
                f32x4 y = x[q][j] * rstd * g[j];
                y.x *= sigmoidf_(o4.x); y.y *= sigmoidf_(o4.y); y.z *= sigmoidf_(o4.z); y.w *= sigmoidf_(o4.w);
                *((unsigned*)((unsigned char*)Y + (size_t)row[q] * DM) + F.lane + 64 * j) = pk4_fp8(y.x, y.y, y.z, y.w, Q8_P); }
        }
    }
}

constexpr int KVLEN = CTXL + SEQ;
__device__ __forceinline__ void phase_c1b(const Frame& F0) {
    Frame F = refresh(F0);
    const int gw = F.bid * 8 + F.wave, NGW = F.G * 8;
    const bf16_t* P = (const bf16_t*)(WSP(F) + WS_P);
    bf16_t* Qb = (bf16_t*)(WSP(F) + WS_AUX + AUX_QK); bf16_t* Kb = (bf16_t*)(WSP(F) + WS_AUX + AUX_KB); bf16_t* Vb = (bf16_t*)(WSP(F) + WS_AUX + AUX_VB);
    const int l32 = F.lane & 31;
    const f32x4 qg = *((const f32x4*)INP(F, I_AQG) + l32), kg = *((const f32x4*)INP(F, I_AKG) + l32);
    float inv[4];
#pragma unroll
    for (int i = 0; i < 4; ++i) { const int d = 4 * l32 + i; inv[i] = exp2f(-(float)(d & 31) * (13.287712379549449f / 32.f)); }
    const bool second = (l32 & 8) != 0;
    const bool colhalf = l32 >= 16;
    for (int row = gw; row < NTOK; row += NGW) {
        const bool isctx = row < NCTXR;
        const int b = isctx ? (row >> 8) : ((row - NCTXR) >> 12), t = isctx ? (row & 255) : ((row - NCTXR) & 4095);
        const int kvpos = isctx ? t : CTXL + t;
        float cs[4], sn[4];
        { const float pos = (float)(colhalf ? (t & 63) : (t >> 6));
#pragma unroll
          for (int i = 0; i < 4; ++i) { const float ang = pos * inv[i]; cs[i] = isctx ? 1.f : __cosf(ang); sn[i] = isctx ? 0.f : __sinf(ang); } }
        const bf16_t* pr = P + (size_t)row * NPAD_B;
#pragma unroll
        for (int j = 0; j < 6; ++j) {
            const u32x2 w = *((const u32x2*)pr + F.lane + 64 * j);
            f32x4 x = (f32x4){bflo(w.x), bfhi(w.x), bflo(w.y), bfhi(w.y)};
            float ss = (x.x * x.x + x.y * x.y) + (x.z * x.z + x.w * x.w);
            ss = half_sum(ss);
            const float rstd = rsqrtf(ss * (1.f / 128.f) + NORM_EPS);
            x = x * rstd * (j < 4 ? qg : kg);
            float xv[4] = {x.x, x.y, x.z, x.w}, ov[4];
#pragma unroll
            for (int i = 0; i < 4; ++i) { const float pv = xch<8>(xv[i], F.lane);
                ov[i] = second ? (pv * sn[i] + xv[i] * cs[i]) : (xv[i] * cs[i] - pv * sn[i]); }
            u32x2 o; o.x = cvt_pk_bf16(ov[0], ov[1]); o.y = cvt_pk_bf16(ov[2], ov[3]);
            if (j < 4) *((u32x2*)(Qb + (size_t)row * DM) + F.lane + 64 * j) = o;
            else *((u32x2*)(Kb + ((size_t)b * KVLEN + kvpos) * 512) + F.lane + 64 * (j - 4)) = o;
        }
#pragma unroll
        for (int j = 0; j < 2; ++j) *((u32x2*)(Vb + ((size_t)b * KVLEN + kvpos) * 512) + F.lane + 64 * j) = *((const u32x2*)(pr + 1536) + F.lane + 64 * j);
    }
}

namespace att {
constexpr int D = 128, NW = 8, QBLK = 32, KVBLK = 64;
constexpr float SCALE = 0.088388347648318440f;
constexpr float THR = 8.f;
constexpr int LDQ = 1024, LDK = 512, LDO = 1024;
constexpr size_t SHM_V = KVBLK * D * 2, SHM_K = KVBLK * D * 2, SHM_ATTN = 2 * SHM_V + 2 * SHM_K + NW * 64 * 4;
using s16x4 = __attribute__((ext_vector_type(4))) short;
using f32x16 = __attribute__((ext_vector_type(16))) float;
#define KSWZ(row, colB) ((row) * 256 + ((colB) ^ (((row) & 7) << 4)))
#define SBAR() __builtin_amdgcn_sched_barrier(0)
__device__ __forceinline__ int crow(int r, int hi) { return (r & 3) + 8 * (r >> 2) + 4 * hi; }
__device__ __forceinline__ unsigned cvtpk(float lo, float hi) { unsigned r; asm volatile("v_cvt_pk_bf16_f32 %0, %1, %2" : "=v"(r) : "v"(lo), "v"(hi)); return r; }
__device__ __forceinline__ void partialSM(f32x16& p0, f32x16& p1, float& m_reg, float& mn, float& alpha) {
  constexpr float C = SCALE * 1.4426950408889634f;
  float pmax = p0[0]; for (int r = 1; r < 16; ++r) pmax = fmaxf(pmax, p0[r]); for (int r = 0; r < 16; ++r) pmax = fmaxf(pmax, p1[r]);
  { auto rr = __builtin_amdgcn_permlane32_swap(__float_as_uint(pmax), __float_as_uint(pmax), false, false);
    pmax = fmaxf(__uint_as_float(rr[0]), __uint_as_float(rr[1])); }
  if (__builtin_expect(__all(pmax - m_reg <= THR / SCALE), 1)) { mn = m_reg; alpha = 1.f; }
  else { mn = fmaxf(m_reg, pmax); alpha = __builtin_amdgcn_exp2f((m_reg - mn) * C); m_reg = mn; }
  float mnC = -mn * C;
  for (int r = 0; r < 16; ++r) p0[r] = fmaf(p0[r], C, mnC); for (int r = 0; r < 16; ++r) p1[r] = fmaf(p1[r], C, mnC);
  for (int r = 0; r < 16; ++r) p0[r] = __builtin_amdgcn_exp2f(p0[r]);
}
__device__ __forceinline__ void finishSM(f32x16& p0, f32x16& p1, float alpha, float& l_reg, bf16x8& pa0, bf16x8& pa1, bf16x8& pa2, bf16x8& pa3) {
  for (int r = 0; r < 16; ++r) p1[r] = __builtin_amdgcn_exp2f(p1[r]);
  float ps = 0; for (int r = 0; r < 16; ++r) ps += p0[r]; for (int r = 0; r < 16; ++r) ps += p1[r];
  { auto rr = __builtin_amdgcn_permlane32_swap(__float_as_uint(ps), __float_as_uint(ps), false, false);
    ps = __uint_as_float(rr[0]) + __uint_as_float(rr[1]); }
  l_reg = l_reg * alpha + ps;
#define PK4(P, BASE, OUT) do { unsigned a0 = cvtpk(P[BASE + 0], P[BASE + 1]), a1 = cvtpk(P[BASE + 2], P[BASE + 3]);   \
    unsigned b0 = cvtpk(P[BASE + 4], P[BASE + 5]), b1 = cvtpk(P[BASE + 6], P[BASE + 7]);                              \
    auto r0 = __builtin_amdgcn_permlane32_swap(a0, b0, false, false); auto r1 = __builtin_amdgcn_permlane32_swap(a1, b1, false, false); \
    u32x4 w = {r0[0], r1[0], r0[1], r1[1]}; OUT = *reinterpret_cast<bf16x8*>(&w); } while (0)
  PK4(p0, 0, pa0); PK4(p0, 8, pa1); PK4(p1, 0, pa2); PK4(p1, 8, pa3);
#undef PK4
}
__device__ __forceinline__ void qkt(f32x16& p0, f32x16& p1, const bf16_t* Ks, const bf16x8* qr, int r32, int hi) {
  p0 = f32x16{}; p1 = f32x16{};
  for (int d0 = 0; d0 < 8; ++d0) { int cb = (d0 * 16 + hi * 8) * 2;
    bf16x8 b0 = *reinterpret_cast<const bf16x8*>((const char*)Ks + KSWZ(r32, cb));
    bf16x8 b1 = *reinterpret_cast<const bf16x8*>((const char*)Ks + KSWZ(32 + r32, cb));
    p0 = __builtin_amdgcn_mfma_f32_32x32x16_bf16(b0, qr[d0], p0, 0, 0, 0);
    p1 = __builtin_amdgcn_mfma_f32_32x32x16_bf16(b1, qr[d0], p1, 0, 0, 0); }
}
__device__ __forceinline__ int v_st(int k, int c) { const int kk = (k & ~0xC) | ((k & 4) << 1) | ((k & 8) >> 1); return ((kk >> 3) * 4 + (c >> 5)) * 512 + ((kk & 7) * 32 + (c & 31)) * 2; }
__device__ __forceinline__ int v_rd_base(int lane) { return ((lane & 3) << 3) | (((lane >> 2) & 3) << 6) | (((lane >> 4) & 1) << 5) | (((lane >> 5) & 1) << 8); }
constexpr int v_rd_off(int d0, int ks, int half) { return d0 * 512 + ks * 4096 + half * 2048; }
template <int OFF> __device__ __forceinline__ s16x4 tr_read(int vb) {
  s16x4 r; asm volatile("ds_read_b64_tr_b16 %0, %1 offset:%2" : "=&v"(r) : "v"(vb), "i"(OFF) : "memory"); return r;
}
template <int D0> __device__ __forceinline__ void pv_one(f32x16& od, int vb, bf16x8 pa0, bf16x8 pa1, bf16x8 pa2, bf16x8 pa3) {
  const s16x4 l0 = tr_read<v_rd_off(D0, 0, 0)>(vb), h0 = tr_read<v_rd_off(D0, 0, 1)>(vb), l1 = tr_read<v_rd_off(D0, 1, 0)>(vb), h1 = tr_read<v_rd_off(D0, 1, 1)>(vb);
  const s16x4 l2 = tr_read<v_rd_off(D0, 2, 0)>(vb), h2 = tr_read<v_rd_off(D0, 2, 1)>(vb), l3 = tr_read<v_rd_off(D0, 3, 0)>(vb), h3 = tr_read<v_rd_off(D0, 3, 1)>(vb);
  asm volatile("s_waitcnt lgkmcnt(0)" ::: "memory"); SBAR();
#define PK(L, H) (bf16x8){L[0], L[1], L[2], L[3], H[0], H[1], H[2], H[3]}
  od = __builtin_amdgcn_mfma_f32_32x32x16_bf16(pa0, PK(l0, h0), od, 0, 0, 0);
  od = __builtin_amdgcn_mfma_f32_32x32x16_bf16(pa1, PK(l1, h1), od, 0, 0, 0);
  od = __builtin_amdgcn_mfma_f32_32x32x16_bf16(pa2, PK(l2, h2), od, 0, 0, 0);
  od = __builtin_amdgcn_mfma_f32_32x32x16_bf16(pa3, PK(l3, h3), od, 0, 0, 0);
#undef PK
}
__device__ __forceinline__ void pv_d0(f32x16* o, int vb, bf16x8 pa0, bf16x8 pa1, bf16x8 pa2, bf16x8 pa3) {
  pv_one<0>(o[0], vb, pa0, pa1, pa2, pa3); pv_one<1>(o[1], vb, pa0, pa1, pa2, pa3); pv_one<2>(o[2], vb, pa0, pa1, pa2, pa3); pv_one<3>(o[3], vb, pa0, pa1, pa2, pa3);
}
__device__ __forceinline__ void attn_dense_body(const bf16_t* __restrict__ Qb, const bf16_t* __restrict__ Kh, const bf16_t* __restrict__ Vh,
                                                unsigned char* __restrict__ Ob, int seq, char* lds, int wv) {
  int tz_ = wv * 64 + lane_now(); asm volatile("" : "+v"(tz_));
  const int tid = tz_, wid = tid >> 6, lane = tid & 63, r32 = lane & 31, hi = lane >> 5;
  bf16_t* V_lds = (bf16_t*)lds; bf16_t* K_lds = (bf16_t*)(lds + 2 * SHM_V);
  float* ws = (float*)(lds + 2 * SHM_V + 2 * SHM_K) + wid * 64; float* li_l = ws; float* al_l = ws + 32;
  float m_reg = -1e30f, l_reg = 0; f32x16 o[4] = {}; bf16x8 qr[8];
  const bf16_t* Qw = Qb + (long)(wid * QBLK + r32) * LDQ + hi * 8;
#pragma unroll
  for (int d0 = 0; d0 < 8; ++d0) qr[d0] = *reinterpret_cast<const bf16x8*>(Qw + d0 * 16);
  const int sr = tid >> 4, sc = (tid & 15) * 8, vst0 = v_st(sr, sc), vst1 = v_st(32 + sr, sc);
  const int vb0 = (int)(uintptr_t)V_lds + v_rd_base(lane);
  struct { bf16x8 vs0, vs1, ks0, ks1; } sr_[2];
#define SLOAD(i, k0) do { sr_[i].vs0 = *reinterpret_cast<const bf16x8*>(&Vh[(long)((k0) + sr) * LDK + sc]); sr_[i].vs1 = *reinterpret_cast<const bf16x8*>(&Vh[(long)((k0) + 32 + sr) * LDK + sc]); \
    sr_[i].ks0 = *reinterpret_cast<const bf16x8*>(&Kh[(long)((k0) + sr) * LDK + sc]); sr_[i].ks1 = *reinterpret_cast<const bf16x8*>(&Kh[(long)((k0) + 32 + sr) * LDK + sc]); } while (0)
#define SWRITE(b, i) do { *(bf16x8*)((char*)V_lds + (b) * SHM_V + vst0) = sr_[i].vs0;          \
    *(bf16x8*)((char*)V_lds + (b) * SHM_V + vst1) = sr_[i].vs1; int kc = sc * 2;               \
    *(bf16x8*)((char*)K_lds + (b) * SHM_K + KSWZ(sr, kc)) = sr_[i].ks0;                       \
    *(bf16x8*)((char*)K_lds + (b) * SHM_K + KSWZ(32 + sr, kc)) = sr_[i].ks1; } while (0)
#define SWAIT() asm volatile("s_waitcnt vmcnt(4)" ::: "memory")
#define RESC(a) do { if (__any((a) < 1.f)) { if (hi == 0) al_l[r32] = (a); asm volatile("s_waitcnt lgkmcnt(0)" ::: "memory"); \
    for (int d = 0; d < 4; ++d) for (int r = 0; r < 16; ++r) o[d][r] *= al_l[crow(r, hi)]; } } while (0)
  f32x16 pA0, pA1, pB0, pB1; float mnA, mnB, alA, alB; bf16x8 pa0, pa1, pa2, pa3; const int NT = seq / KVBLK;
  constexpr int SE = 0, SO = 1;
  SLOAD(SE, 0); asm volatile("s_waitcnt vmcnt(0)" ::: "memory"); SWRITE(0, SE); __syncthreads();
  qkt(pA0, pA1, K_lds, qr, r32, hi); partialSM(pA0, pA1, m_reg, mnA, alA);
  SLOAD(SO, KVBLK); if (2 < NT) SLOAD(SE, 2 * KVBLK);
  SWAIT(); SWRITE(1, SO); __syncthreads();
  for (int j = 1; j + 1 < NT; j += 2) {
    SBAR(); qkt(pB0, pB1, (bf16_t*)((char*)K_lds + SHM_K), qr, r32, hi);
    finishSM(pA0, pA1, alA, l_reg, pa0, pa1, pa2, pa3); SBAR();
    SLOAD(SO, (j + 2) * KVBLK); SBAR();
    pv_d0(o, vb0, pa0, pa1, pa2, pa3); partialSM(pB0, pB1, m_reg, mnB, alB);
    __syncthreads(); SWAIT(); SWRITE(0, SE);
    RESC(alB); __syncthreads();
    SBAR(); qkt(pA0, pA1, K_lds, qr, r32, hi);
    finishSM(pB0, pB1, alB, l_reg, pa0, pa1, pa2, pa3); SBAR();
    if (j + 3 < NT) SLOAD(SE, (j + 3) * KVBLK); SBAR();
    pv_d0(o, vb0 + (int)SHM_V, pa0, pa1, pa2, pa3); partialSM(pA0, pA1, m_reg, mnA, alA);
    __syncthreads(); SWAIT(); SWRITE(1, SO);
    RESC(alA); __syncthreads();
  }
  SBAR(); qkt(pB0, pB1, (bf16_t*)((char*)K_lds + SHM_K), qr, r32, hi);
  finishSM(pA0, pA1, alA, l_reg, pa0, pa1, pa2, pa3); SBAR();
  pv_d0(o, vb0, pa0, pa1, pa2, pa3); partialSM(pB0, pB1, m_reg, mnB, alB);
  __syncthreads(); RESC(alB);
  finishSM(pB0, pB1, alB, l_reg, pa0, pa1, pa2, pa3); SBAR();
  pv_d0(o, vb0 + (int)SHM_V, pa0, pa1, pa2, pa3);
  if (hi == 0) li_l[r32] = l_reg; asm volatile("s_waitcnt lgkmcnt(0)" ::: "memory");
  float rli[16];
#pragma unroll
  for (int r = 0; r < 16; ++r) rli[r] = __builtin_amdgcn_rcpf(li_l[crow(r, hi)]);
  unsigned char* Ow = Ob + (long)(wid * QBLK) * LDO;
#pragma unroll
  for (int r = 0; r < 16; ++r) { int orow = crow(r, hi);
    for (int d0 = 0; d0 < 4; ++d0) { const float yv = __builtin_amdgcn_fmed3f(o[d0][r] * rli[r] * Q8_P, -448.f, 448.f); Ow[(long)orow * LDO + d0 * 32 + r32] = (unsigned char)(__builtin_amdgcn_cvt_pk_fp8_f32(yv, yv, 0, false) & 0xff); } }
#undef SLOAD
#undef SWRITE
#undef SWAIT
#undef RESC
}
#undef KSWZ
#undef SBAR
}

__device__ __forceinline__ void phase_c2b(const Frame& F0) {
    Frame F = refresh(F0);
    const bf16_t* Qb = (const bf16_t*)(WSP(F) + WS_AUX + AUX_QK); const bf16_t* Kb = (const bf16_t*)(WSP(F) + WS_AUX + AUX_KB); const bf16_t* Vb = (const bf16_t*)(WSP(F) + WS_AUX + AUX_VB);
    bf16_t* Y = (bf16_t*)(WSP(F) + WS_YPRE);
    for (int i = 0; i < 3; ++i) {
        int b, h, seq; size_t qrow;
        if (i < 2) { const int x = F.bid & 7, j = F.bid >> 3, g = 8 * i + x; b = g >> 2; h = (g & 3) * 2 + (j >> 4); qrow = (size_t)NCTXR + (size_t)b * SEQ + (size_t)(j & 15) * 256; seq = KVLEN; }
        else { if (F.bid >= 32) break; b = F.bid >> 3; h = F.bid & 7; qrow = (size_t)b * CTXL; seq = CTXL; }
        const size_t kvoff = (size_t)b * KVLEN * 512 + (size_t)(h >> 1) * 128;
        att::attn_dense_body(Qb + qrow * DM + h * 128, Kb + kvoff, Vb + kvoff, (unsigned char*)Y + qrow * DM + h * 128, seq, (char*)(unsigned char*)F.lds, F.wave);
        __syncthreads();
    }
}

__device__ __forceinline__ void phase_c1c(const Frame& F0) {
    Frame F = refresh(F0);
    const bf16_t* P = (const bf16_t*)(WSP(F) + WS_P);
    LAS float* alow = (LAS float*)F.lds;
    const int c = F.tid;
    for (int it = F.bid; it < (NTOK / 64) * 2; it += F.G) {
        const int tc = it >> 1, dir = it & 1, row0 = tc * 64;
        bf16_t* QT = (bf16_t*)(WSP(F) + WS_AUX + AUX_QT) + (size_t)dir * NTOK * 512;
        bf16_t* KH = (bf16_t*)(WSP(F) + WS_AUX + AUX_KHT) + (size_t)dir * NTOK * 512;
        float* DEC = (float*)(WSP(F) + WS_AUX + AUX_DEC) + (size_t)(dir * (NTOK / 64) + tc) * 512;
        __syncthreads();
        for (int i = F.tid; i < 1024; i += 512) { const int t = i >> 4, r = i & 15; alow[i] = bf2f(P[(size_t)(row0 + t) * NPAD_A + 3072 + dir * 16 + r]); }
        float w2[16];
#pragma unroll
        for (int r = 0; r < 16; ++r) w2[r] = INP(F, I_GAW2)[(size_t)(dir * 16 + r) * 512 + c];
        const float ab = INP(F, I_GAB)[dir * 512 + c];
        __syncthreads();
        float tot = 0.f, lav[64];
#pragma unroll
        for (int t = 0; t < 64; ++t) { float s_ = ab;
#pragma unroll
            for (int r = 0; r < 16; ++r) s_ += alow[t * 16 + r] * w2[r];
            lav[t] = logsigmoidf_(s_) * (1.f / 16.f); tot += lav[t]; }
        float pex = 0.f;
        bf16_t qn[16], kn[16];
#pragma unroll
        for (int i = 0; i < 16; ++i) { qn[i] = P[(size_t)(row0 + i) * NPAD_A + c]; kn[i] = P[(size_t)(row0 + i) * NPAD_A + 512 + c]; }
#pragma unroll
        for (int g = 0; g < 4; ++g) {
            bf16_t qc[16], kc[16];
#pragma unroll
            for (int i = 0; i < 16; ++i) { qc[i] = qn[i]; kc[i] = kn[i]; }
            if (g < 3) {
#pragma unroll
                for (int i = 0; i < 16; ++i) { qn[i] = P[(size_t)(row0 + 16 * (g + 1) + i) * NPAD_A + c]; kn[i] = P[(size_t)(row0 + 16 * (g + 1) + i) * NPAD_A + 512 + c]; } }
#pragma unroll
            for (int i = 0; i < 16; ++i) {
                const int t = 16 * g + i;
                const float la = lav[t];
                const float bb = dir ? (tot - pex) : (pex + la);
                pex += la;
                const size_t row = (size_t)(row0 + t);
                const float q = bf2f(qc[i]) * 0.08838834764831845f, k = bf2f(kc[i]);
                QT[row * 512 + c] = f2bf(q * __expf(bb - tot)); KH[row * 512 + c] = f2bf(k * __expf(tot - bb));
            }
        }
        DEC[c] = __expf(tot);
    }
}

__device__ __forceinline__ void phase_c2c(const Frame& F0, bool last_layer, int cl0, int cl1) {
    Frame F = refresh(F0);
    if (F.bid >= 64) { if (cl1 - cl0 == 1) { if (F.wave < 4) moe_convert(F, cl0, cl1, (F.bid - 64) * 4 + F.wave, (F.G - 64) * 4); } else if (cl1 > cl0) moe_convert(F, cl0, cl1, (F.bid - 64) * 8 + F.wave, (F.G - 64) * 8); return; }
    const int b = F.bid >> 4, h = (F.bid >> 2) & 3, dir = (F.bid >> 1) & 1, vh = F.bid & 1;
    constexpr int LQ = 136, LD = 72, LH = 136, NCH = (CTXL + SEQ) / 64;
    constexpr int OFF_KH = 64 * LQ * 2, OFF_V = OFF_KH + 16384, OFF_DEC = OFF_V + 16384, IN_BYTES = OFF_DEC + 512;
    constexpr int OFF_SB = 2 * IN_BYTES, OFF_HS = OFF_SB + 64 * LD * 2, LDS_USED = OFF_HS + 64 * LH * 2;
    static_assert(LDS_USED <= MISC_OFF, "C2c LDS map");
    LAS unsigned char* L0 = F.lds;
    LAS bf16_t* Sb = (LAS bf16_t*)(L0 + OFF_SB); LAS bf16_t* Hs = (LAS bf16_t*)(L0 + OFF_HS);
    { LAS unsigned* z = (LAS unsigned*)L0; for (int i = F.tid; i < LDS_USED / 4; i += 512) z[i] = 0u; }
    const bf16_t* QT = (const bf16_t*)(WSP(F) + WS_AUX + AUX_QT) + (size_t)dir * NTOK * 512;
    const bf16_t* KH = (const bf16_t*)(WSP(F) + WS_AUX + AUX_KHT) + (size_t)dir * NTOK * 512;
    const float* DEC = (const float*)(WSP(F) + WS_AUX + AUX_DEC) + (size_t)dir * (NTOK / 64) * 512;
    const bf16_t* P = (const bf16_t*)(WSP(F) + WS_P);
    bf16_t* HD = (bf16_t*)(WSP(F) + WS_HDIR) + (size_t)dir * NTOK * DM;
    const int fr = F.lane & 15, fq = F.lane >> 4;
    u32x4 rq[2], rh[2], rv[2]; float rd = 0.f;
#define C2C_LOAD(c) do { const int c_ = (c); const int p0_ = c_ * 64; \
        const int tc_ = (c_ < 4) ? (b * 4 + (dir ? 3 - c_ : c_)) : (16 + b * 64 + (dir ? 63 - (c_ - 4) : (c_ - 4))); \
        _Pragma("unroll") for (int i = 0; i < 2; ++i) { const int pc = F.tid + 512 * i, r_ = pc >> 4, ch_ = pc & 15; const size_t row_ = (size_t)scan_row(b, dir, p0_ + r_); \
            rq[i] = *(const u32x4*)(QT + row_ * 512 + h * 128 + ch_ * 8); rh[i] = *(const u32x4*)(KH + row_ * 512 + h * 128 + ch_ * 8); \
            rv[i] = *(const u32x4*)(P + row_ * NPAD_A + 1024 + h * 256 + vh * 128 + ch_ * 8); } \
        if (F.tid < 128) rd = DEC[(size_t)tc_ * 512 + h * 128 + F.tid]; } while (0)
#define C2C_STAGE(buf) do { LAS unsigned char* B_ = L0 + (buf) * IN_BYTES; \
        _Pragma("unroll") for (int i = 0; i < 2; ++i) { const int pc = F.tid + 512 * i, r_ = pc >> 4, ch_ = pc & 15; \
            *(LAS u32x4*)(B_ + (r_ * LQ + ch_ * 8) * 2) = rq[i]; *(LAS u32x4*)(B_ + OFF_KH + off_b(r_, ch_)) = rh[i]; *(LAS u32x4*)(B_ + OFF_V + off_b(r_, ch_)) = rv[i]; } \
        if (F.tid < 128) ((LAS float*)(B_ + OFF_DEC))[F.tid] = rd; } while (0)
    __syncthreads();
    C2C_LOAD(0); C2C_STAGE(0); C2C_LOAD(1);
    f32x4 ST[8];
#pragma unroll
    for (int i = 0; i < 8; ++i) ST[i] = (f32x4){0.f, 0.f, 0.f, 0.f};
    const unsigned lbase = (unsigned)(size_t)L0;
    for (int c = 0; c <= NCH; ++c) {
        __syncthreads();
        const int buf = c & 1;
        if (c + 1 < NCH) C2C_STAGE(buf ^ 1);
        if (c > 0 && !(last_layer && c - 1 < CTXL / 64)) {
            const int row0 = scan_row(b, dir, (c - 1) * 64), rstep = dir ? -1 : 1;
#pragma unroll
            for (int i = 0; i < 2; ++i) { const int pc = F.tid + 512 * i, r_ = pc >> 4, ch_ = pc & 15;
                *(u32x4*)(HD + (size_t)(row0 + rstep * r_) * DM + h * 256 + vh * 128 + ch_ * 8) = *(const LAS u32x4*)(Hs + r_ * LH + ch_ * 8); }
        }
        if (c == NCH) break;
        if (c + 2 < NCH) C2C_LOAD(c + 2);
        const LAS bf16_t* Qs = (const LAS bf16_t*)(L0 + buf * IN_BYTES);
        const LAS unsigned char* KHi = L0 + buf * IN_BYTES + OFF_KH;
        const LAS float* decs = (const LAS float*)(L0 + buf * IN_BYTES + OFF_DEC);
        for (int id = F.wave; id < 10; id += 8) {
            int ti, si; tri_tile(id, ti, si);
            f32x4 acc = (f32x4){0.f, 0.f, 0.f, 0.f};
#pragma unroll
            for (int kk = 0; kk < 4; ++kk) acc = MMA16(lds_frag(Qs, LQ, ti * 16, kk * 32, fr, fq), *(const LAS bf16x8*)(KHi + off_b(si * 16 + fr, 4 * kk + fq)), acc);
            const int s_ = si * 16 + fr;
#pragma unroll
            for (int j = 0; j < 4; ++j) { const int t = ti * 16 + fq * 4 + j; Sb[t * LD + s_] = f2bf((s_ <= t) ? acc[j] : 0.f); }
        }
        __syncthreads();
        const unsigned vbase = lbase + buf * IN_BYTES + OFF_V, kbase = lbase + buf * IN_BYTES + OFF_KH;
        s16x4 v00 = tr_read(vbase + tr_addr16(F.lane, F.wave, 0, 0)), v01 = tr_read(vbase + tr_addr16(F.lane, F.wave, 0, 1));
        s16x4 v10 = tr_read(vbase + tr_addr16(F.lane, F.wave, 1, 0)), v11 = tr_read(vbase + tr_addr16(F.lane, F.wave, 1, 1));
        TR_WAIT2(v00, v01); TR_WAIT2(v10, v11);
        const bf16x8 vf0 = cat4(v00, v01), vf1 = cat4(v10, v11);
#pragma unroll
        for (int di = 0; di < 8; ++di) ST[di] = ST[di] * *(const LAS f32x4*)(decs + di * 16 + fq * 4);
        bf16x8 sbf[4];
#pragma unroll
        for (int kk = 0; kk < 4; ++kk) {
            u32x4 w; w.x = cvt_pk_bf16(ST[2 * kk][0], ST[2 * kk][1]); w.y = cvt_pk_bf16(ST[2 * kk][2], ST[2 * kk][3]); w.z = cvt_pk_bf16(ST[2 * kk + 1][0], ST[2 * kk + 1][1]); w.w = cvt_pk_bf16(ST[2 * kk + 1][2], ST[2 * kk + 1][3]);
            sbf[kk] = __builtin_bit_cast(bf16x8, w); }
#pragma unroll
        for (int ti = 0; ti < 4; ++ti) {
            f32x4 a = (f32x4){0.f, 0.f, 0.f, 0.f};
#pragma unroll
            for (int kk = 0; kk < 4; ++kk) {
                const u32x2 qlo = *(const LAS u32x2*)(Qs + (ti * 16 + fr) * LQ + kk * 32 + 4 * fq), qhi = *(const LAS u32x2*)(Qs + (ti * 16 + fr) * LQ + kk * 32 + 16 + 4 * fq);
                const u32x4 qw = (u32x4){qlo.x, qlo.y, qhi.x, qhi.y};
                a = MMA16(__builtin_bit_cast(bf16x8, qw), sbf[kk], a); }
            a = MMA16(lds_frag(Sb, LD, ti * 16, 0, fr, fq), vf0, a);
            if (ti >= 2) a = MMA16(lds_frag(Sb, LD, ti * 16, 32, fr, fq), vf1, a);
#pragma unroll
            for (int j = 0; j < 4; ++j) Hs[(ti * 16 + fq * 4 + j) * LH + F.wave * 16 + fr] = f2bf(a[j]);
        }
#pragma unroll
        for (int dg = 0; dg < 2; ++dg) {
            s16x4 kq[4][4];
#pragma unroll
            for (int i = 0; i < 4; ++i) { const int di = dg * 4 + i; kq[i][0] = tr_read(kbase + tr_addr16(F.lane, di, 0, 0)); kq[i][1] = tr_read(kbase + tr_addr16(F.lane, di, 0, 1));
                kq[i][2] = tr_read(kbase + tr_addr16(F.lane, di, 1, 0)); kq[i][3] = tr_read(kbase + tr_addr16(F.lane, di, 1, 1)); }
#pragma unroll
            for (int i = 0; i < 4; ++i) { TR_WAIT2(kq[i][0], kq[i][1]); TR_WAIT2(kq[i][2], kq[i][3]); }
#pragma unroll
            for (int i = 0; i < 4; ++i) { const int di = dg * 4 + i; f32x4 a = ST[di];
                a = MMA16(cat4(kq[i][0], kq[i][1]), vf0, a); a = MMA16(cat4(kq[i][2], kq[i][3]), vf1, a); ST[di] = a; }
        }
    }
#undef C2C_LOAD
#undef C2C_STAGE
}

__device__ __forceinline__ void phase_c3c(const Frame& F0) {
    Frame F = refresh(F0);
    const int gw = F.bid * 8 + F.wave, NGW = F.G * 8;
    const bf16_t* P = (const bf16_t*)(WSP(F) + WS_P);
    const bf16_t* H0 = (const bf16_t*)(WSP(F) + WS_HDIR); const bf16_t* H1 = H0 + (size_t)NTOK * DM;
    bf16_t* Y = (bf16_t*)(WSP(F) + WS_YPRE);
    const float* ng = INP(F, I_GNG);
    f32x4 g[4];
#pragma unroll
    for (int j = 0; j < 4; ++j) g[j] = *((const f32x4*)ng + F.lane + 64 * j);
    constexpr int NR = 4;
    for (int row0 = gw; row0 < NTOK; row0 += NR * NGW) {
        int row[NR]; bool ok[NR]; u32x2 a[NR][4], bq[NR][4], gv[NR][4];
#pragma unroll
        for (int q = 0; q < NR; ++q) { row[q] = row0 + q * NGW; ok[q] = row[q] < NTOK; if (!ok[q]) row[q] = row0;
#pragma unroll
            for (int j = 0; j < 4; ++j) {
                a[q][j] = *((const u32x2*)(H0 + (size_t)row[q] * DM) + F.lane + 64 * j); bq[q][j] = *((const u32x2*)(H1 + (size_t)row[q] * DM) + F.lane + 64 * j);
                gv[q][j] = *((const u32x2*)(P + (size_t)row[q] * NPAD_A + 2048) + F.lane + 64 * j); } }
        f32x4 x[NR][4]; float ss[NR][4];
#pragma unroll
        for (int q = 0; q < NR; ++q)
#pragma unroll
            for (int j = 0; j < 4; ++j) { x[q][j] = (f32x4){bflo(a[q][j].x) + bflo(bq[q][j].x), bfhi(a[q][j].x) + bfhi(bq[q][j].x), bflo(a[q][j].y) + bflo(bq[q][j].y), bfhi(a[q][j].y) + bfhi(bq[q][j].y)};
                ss[q][j] = (x[q][j].x * x[q][j].x + x[q][j].y * x[q][j].y) + (x[q][j].z * x[q][j].z + x[q][j].w * x[q][j].w); }
#pragma unroll
        for (int q = 0; q < NR; ++q)
#pragma unroll
            for (int j = 0; j < 4; ++j) ss[q][j] = wave_sum(ss[q][j], F.lane);
#pragma unroll
        for (int q = 0; q < NR; ++q) {
            if (!ok[q]) continue;
#pragma unroll
            for (int j = 0; j < 4; ++j) {
                const float rstd = rsqrtf(ss[q][j] * (1.f / 256.f) + NORM_EPS);
                const f32x4 g4 = (f32x4){bflo(gv[q][j].x), bfhi(gv[q][j].x), bflo(gv[q][j].y), bfhi(gv[q][j].y)};
                f32x4 y = x[q][j] * rstd * g[j];
                y.x *= g4.x * sigmoidf_(g4.x); y.y *= g4.y * sigmoidf_(g4.y); y.z *= g4.z * sigmoidf_(g4.z); y.w *= g4.w * sigmoidf_(g4.w);
                *((unsigned*)((unsigned char*)Y + (size_t)row[q] * DM) + F.lane + 64 * j) = pk4_fp8(y.x, y.y, y.z, y.w, Q8_P); }
        }
    }
}

#ifndef PHSEL
#define PHSEL 0xFFFF
#endif
#define SEL(n) ((PHSEL >> (n)) & 1)
constexpr int N_PHASES = 42;
__global__ void __launch_bounds__(512, 2) mk_fwd(Args args) {
    extern __shared__ __attribute__((aligned(16))) unsigned char lds[];
    Frame F;
    F.lds = (LAS unsigned char*)lds;
    F.tid = threadIdx.x; F.lane = F.tid & 63; F.wave = __builtin_amdgcn_readfirstlane(F.tid >> 6);
    F.G = gridDim.x; F.bid = blockIdx.x;
    F.ka = (const CAS char*)__builtin_amdgcn_kernarg_segment_ptr();
    F.out_ = *(GAS float* const CAS*)(F.ka + 224); F.ws_ = *(GAS unsigned char* const CAS*)(F.ka + 232);
    volatile LAS unsigned* misc = (volatile LAS unsigned*)(F.lds + MISC_OFF);
    if (F.tid < 4) misc[F.tid] = 0u;
    __syncthreads();
    unsigned* ctl = (unsigned*)(WSP(F) + WS_CTL);
    XcdBarrier bar; bar.bar = ctl + CW_BAR; bar.x = 0; bar.st = misc; bar.wave = F.wave;
    const int lo = args.ph_lo, hi = args.ph_hi;
    if (hi - lo > 1) bar = xcd_barrier_post(ctl + CW_BAR, misc, F.wave);
#define IN(k) (lo <= (k) && (k) < hi)
#define END(k) do { if ((k) + 1 < hi) xcd_barrier(bar); } while (0)

    if (SEL(0) && IN(0)) { phase_p0(F); END(0); }
    for (int l = 0; l < DEPTH; ++l) {
        const int base = 1 + 10 * l, kind = l % 3, jl = l / 3;
        const int npad = (kind == 1) ? NPAD_B : NPAD_A;
        if (SEL(1) && IN(base + 0)) { phase_a(F, l); END(base + 0); }
        if (SEL(2) && IN(base + 1)) {
            g8::StaticSched<false> S; S.init(WSP(F) + WS_U, WSP(F) + WS_WIN + (size_t)l * 7 * MiB, NTOK, npad, F.G, F.bid);
            g8::EpiBf16 E{(bf16_t*)(WSP(F) + WS_P), npad};
            g8::gemm_phase(F.lds, S, E, (const char*)WSP(F), F.wave);
            END(base + 1);
        }
        if (kind == 0) {
            if (SEL(3) && IN(base + 2)) { phase_c1a(F, jl); END(base + 2); }
            if (SEL(4) && IN(base + 3)) { phase_c2a(F, l == DEPTH - 1, l == 0 ? 0 : 3, l == 0 ? 2 : 4); END(base + 3); }
            if (SEL(5) && IN(base + 4)) { phase_c3a(F, jl); END(base + 4); }
        } else if (kind == 1) {
            if (SEL(6) && IN(base + 2)) { phase_c1b(F); END(base + 2); }
            if (SEL(7) && IN(base + 3)) { phase_c2b(F); END(base + 3); }
        } else {
            if (SEL(8) && IN(base + 2)) { phase_c1c(F); END(base + 2); }
            if (SEL(9) && IN(base + 3)) { phase_c2c(F, l == DEPTH - 1, 2, 3); END(base + 3); }
            if (SEL(10) && IN(base + 4)) { phase_c3c(F); END(base + 4); }
        }
        if (SEL(11) && IN(base + 5)) {
            const bool lastl = (l == DEPTH - 1);
            g8::StaticSched<true> S; S.init(WSP(F) + WS_YPRE, WSP(F) + WS_WOUT + (size_t)l * 1 * MiB, lastl ? NLATR : NTOK, DM, F.G, F.bid, lastl ? NCTXR : 0);
            g8::EpiDelta E{(bf16_t*)(WSP(F) + WS_DELTA), (const float*)(WSP(F) + WS_MODV) + (size_t)(l * 5) * 6144 + 2 * 1024};
            g8::gemm_phase(F.lds, S, E, (const char*)WSP(F), F.wave);
            END(base + 5);
        }
        if (SEL(12) && IN(base + 6)) { phase_e(F, l); END(base + 6); }
        if (SEL(13) && IN(base + 7)) {
            moe_tstart_table(F, l);
            const LAS int* tab = (const LAS int*)(F.lds + TAB_OFF);
            g8::MoeSched<true> S{(const char*)(WSP(F) + WS_U), (const char*)(WSP(F) + WS_WGU) + (size_t)l * 32 * 2048 * 1024, (const int*)(WSP(F) + WS_SLOTTOK), tab, __builtin_amdgcn_readfirstlane(tab[64]) * 8, F.G, F.bid};
            g8::EpiSwiglu E{WSP(F) + WS_HDN, INP(F, I_BGU) + (size_t)l * 32 * 2048};
            g8::gemm_phase(F.lds, S, E, (const char*)WSP(F), F.wave);
            END(base + 7);
        }
        if (SEL(14) && IN(base + 8)) {
#if MK_MULTI
            moe_tstart_table(F, l);
#endif
            const LAS int* tab = (const LAS int*)(F.lds + TAB_OFF);
            g8::MoeSched<false> S{(const char*)(WSP(F) + WS_HDN), (const char*)(WSP(F) + WS_WD) + (size_t)l * 32 * 1024 * 1024, (const int*)(WSP(F) + WS_SLOTTOK), tab, __builtin_amdgcn_readfirstlane(tab[64]) * 4, F.G, F.bid};
            g8::EpiDown E{WSP(F) + WS_Y2, INP(F, I_BD) + (size_t)l * 32 * 1024};
            g8::gemm_phase(F.lds, S, E, (const char*)WSP(F), F.wave);
            END(base + 8);
        }
    }
    if (SEL(1) && IN(41)) phase_a(F, 4);
#if defined(DBG_STOP)
    if (lo == 100 && (long)DBG_DUMP_OFF >= 0) {
        const size_t n = (size_t)NLATR * DM; float* o = OUTP(F);
        for (size_t i = (size_t)F.bid * 512 + F.tid; i < n; i += (size_t)F.G * 512) {
            float acc = 0.f;
            for (size_t j = i; j < (size_t)DBG_DUMP_TOTAL; j += n) {
                if (DBG_DUMP_BF16) acc += bf2f(((const bf16_t*)(WSP(F) + (size_t)DBG_DUMP_OFF))[j]);
                else acc += ((const float*)(WSP(F) + (size_t)DBG_DUMP_OFF))[j]; }
            o[i] = acc;
        }
    }
#endif
#undef IN
#undef END
}

extern "C" void kernel_launch(void* const* d_in, const int* in_sizes, int n_in, void* d_out, int out_size, void* d_ws, size_t ws_size, hipStream_t stream) {
    static int ready = 0;
    if (ready == 0) {
        if (n_in != 28 || out_size != NLATR * DM || ws_size < WS_END) { fprintf(stderr, "kernel_launch: unexpected shapes (n_in %d out %d ws %zu)\n", n_in, out_size, ws_size); ready = -1; return; }
        if (hipFuncSetAttribute((const void*)mk_fwd, hipFuncAttributeMaxDynamicSharedMemorySize, LDS_BYTES) != hipSuccess) { fprintf(stderr, "kernel_launch: hipFuncSetAttribute failed\n"); ready = -1; return; }
        int per_cu = 0;
        if (hipOccupancyMaxActiveBlocksPerMultiprocessor(&per_cu, (const void*)mk_fwd, 512, LDS_BYTES) != hipSuccess || per_cu < 1)
            fprintf(stderr, "kernel_launch: occupancy query reports %d workgroups per CU\n", per_cu);
        (void)hipGetLastError();
        ready = 1;
    }
    if (ready < 0) return;
    (void)hipMemsetAsync((char*)d_ws + WS_CTL, 0, CTL_ZERO_BYTES, stream);
    Args a{};
    for (int i = 0; i < 28; ++i) a.in[i] = (const float*)d_in[i];
    a.out = (float*)d_out; a.ws = (unsigned char*)d_ws;
#if MK_MULTI
#if defined(DBG_STOP)
    for (int k = 0; k <= DBG_STOP; ++k) {
#else
    for (int k = 0; k < N_PHASES; ++k) {
#endif
        const int l = (k - 1) / 10, j = (k - 1) % 10;
        if (k > 0 && k < 41) { if (j == 9) continue; if (j == 4 && (l % 3) == 1) continue; }
        a.ph_lo = k; a.ph_hi = k + 1;
        hipLaunchKernelGGL(mk_fwd, dim3(256), dim3(512), LDS_BYTES, stream, a);
    }
#if defined(DBG_STOP)
    a.ph_lo = 100; a.ph_hi = 101;
    hipLaunchKernelGGL(mk_fwd, dim3(256), dim3(512), LDS_BYTES, stream, a);
#endif
#else
    a.ph_lo = 0; a.ph_hi = N_PHASES;
    hipLaunchKernelGGL(mk_fwd, dim3(256), dim3(512), LDS_BYTES, stream, a);
#endif
    const hipError_t le = hipPeekAtLastError();
    if (le != hipSuccess) fprintf(stderr, "kernel_launch: launch failed: %s\n", hipGetErrorName(le));
}
```
